# Optimizing an MI355X kernel written in HIP

```python
import math
import jax, jax.numpy as jnp
from jax import lax
import numpy as np

D_MODEL = 1024
BATCH = 32
SEQ = 2048
DEPTH = 1
DEC_BATCH = 32
DEC_SEQ = 64
PAST_LEN = 1024

CHUNK = 64
MIX_WIDTH = D_MODEL
SB_HEAD_DIM = 64
SB_HEADS = (MIX_WIDTH // 2) // SB_HEAD_DIM
SB_WIDTH = SB_HEADS * SB_HEAD_DIM
SB_BLOCK = 128
SSM_HEAD_DIM = 64
SSM_WIDTH = MIX_WIDTH - SB_WIDTH
SSM_HEADS = SSM_WIDTH // SSM_HEAD_DIM
SSM_GROUPS = 2
SSM_STATE = 64
CONV_WIDTH = 4
CONV_CH = SSM_WIDTH + 2 * SSM_GROUPS * SSM_STATE
D_FF = 4 * D_MODEL
EPS = 1e-5
IN_PROJ = 3 * SB_WIDTH + SSM_WIDTH + CONV_CH + SSM_HEADS
SPLITS = (SB_WIDTH, 2 * SB_WIDTH, 3 * SB_WIDTH, 3 * SB_WIDTH + SSM_WIDTH,
          3 * SB_WIDTH + SSM_WIDTH + CONV_CH)

kernel_name = "stickbreak_ssd_hybrid_stream_step"


def rms_norm(x, w):
    xf = x.astype(jnp.float32)
    xf = xf * lax.rsqrt(jnp.mean(xf * xf, axis=-1, keepdims=True) + EPS)
    return (xf * w.astype(jnp.float32)).astype(x.dtype)


def stick_breaking_block(q, k, v, q_pos):
    k_pos = jnp.arange(k.shape[1])
    z = jnp.einsum("bqhd,bkhd->bhqk", q, k).astype(jnp.float32) * (SB_HEAD_DIM ** -0.5)
    visible = k_pos[None, :] < q_pos[:, None]
    log_beta = jax.nn.log_sigmoid(z)
    log_keep = jnp.where(visible, jax.nn.log_sigmoid(-z), 0.0)
    later = lax.cumsum(log_keep, axis=3, reverse=True) - log_keep
    attn = jnp.where(visible, jnp.exp(log_beta + later), 0.0)
    return jnp.einsum("bhqk,bkhd->bqhd", attn.astype(v.dtype), v)


def causal_conv(xbc, buf, w, b):
    L = xbc.shape[1]
    xp = jnp.concatenate([buf.astype(xbc.dtype), xbc], axis=1)
    out = b
    for i in range(CONV_WIDTH):
        out = out + xp[:, i:i + L] * w[i]
    return jax.nn.silu(out), xp[:, xp.shape[1] - (CONV_WIDTH - 1):]


def segsum(a):
    T = a.shape[-1]
    rep = jnp.broadcast_to(a[..., :, None], a.shape + (T,))
    rep = jnp.where(jnp.tril(jnp.ones((T, T), bool), -1), rep, 0.0)
    cs = jnp.cumsum(rep, axis=-2)
    return jnp.where(jnp.tril(jnp.ones((T, T), bool)), cs, -jnp.inf)


def ssd_scan(x, dt, A, Bm, Cm, h0):
    Bsz, L = x.shape[:2]
    Q = min(CHUNK, L)
    nc = L // Q
    rep = SSM_HEADS // SSM_GROUPS
    Bc = jnp.repeat(Bm, rep, axis=2).reshape(Bsz, nc, Q, SSM_HEADS, SSM_STATE)
    Cc = jnp.repeat(Cm, rep, axis=2).reshape(Bsz, nc, Q, SSM_HEADS, SSM_STATE)
    xc = (x * dt[..., None]).reshape(Bsz, nc, Q, SSM_HEADS, SSM_HEAD_DIM)
    a = (dt * A).reshape(Bsz, nc, Q, SSM_HEADS).transpose(0, 3, 1, 2)
    a_cum = jnp.cumsum(a, axis=-1)
    decay_in = jnp.exp(segsum(a))
    y_diag = jnp.einsum("bclhn,bcshn,bhcls,bcshp->bclhp", Cc, Bc, decay_in, xc)
    decay_to_end = jnp.exp(a_cum[..., -1:] - a_cum)
    chunk_states = jnp.einsum("bclhn,bhcl,bclhp->bchpn", Bc, decay_to_end, xc)
    chunk_decay = jnp.exp(a_cum[..., -1])

    def step(h, inp):
        st, dec = inp
        return dec[..., None, None] * h + st, h

    h_final, h_prev = lax.scan(step, h0, (chunk_states.transpose(1, 0, 2, 3, 4),
                                          chunk_decay.transpose(2, 0, 1)))
    h_prev = h_prev.transpose(1, 0, 2, 3, 4)
    y_off = jnp.einsum("bclhn,bchpn,bhcl->bclhp", Cc, h_prev, jnp.exp(a_cum))
    return (y_diag + y_off).reshape(Bsz, L, SSM_HEADS, SSM_HEAD_DIM), h_final


def mamba2_mixer(z, xbc, dt_raw, conv_buf, h0, conv_w, conv_b, dt_bias, a_log, d_skip, ssm_norm_w):
    Bsz, L = z.shape[:2]
    xbc, new_buf = causal_conv(xbc, conv_buf, conv_w, conv_b)
    xf = xbc.astype(jnp.float32)
    xs = xf[..., :SSM_WIDTH].reshape(Bsz, L, SSM_HEADS, SSM_HEAD_DIM)
    Bm = xf[..., SSM_WIDTH:SSM_WIDTH + SSM_GROUPS * SSM_STATE].reshape(Bsz, L, SSM_GROUPS, SSM_STATE)
    Cm = xf[..., SSM_WIDTH + SSM_GROUPS * SSM_STATE:].reshape(Bsz, L, SSM_GROUPS, SSM_STATE)
    dt = jax.nn.softplus(dt_raw.astype(jnp.float32) + dt_bias.astype(jnp.float32))
    A = -jnp.exp(a_log.astype(jnp.float32))
    y, h_final = ssd_scan(xs, dt, A, Bm, Cm, h0.astype(jnp.float32))
    y = y + d_skip.astype(jnp.float32)[:, None] * xs
    y = y.reshape(Bsz, L, SSM_WIDTH) * jax.nn.silu(z.astype(jnp.float32))
    yg = y.reshape(Bsz, L, SSM_GROUPS, SSM_WIDTH // SSM_GROUPS)
    yg = yg * lax.rsqrt(jnp.mean(yg * yg, axis=-1, keepdims=True) + EPS)
    y = yg.reshape(Bsz, L, SSM_WIDTH) * ssm_norm_w.astype(jnp.float32)
    return y.astype(z.dtype), new_buf, h_final


def layer_forward(x, k_past, v_past, conv_buf, h0, norm1_w, w_in, conv_w, conv_b,
                  dt_bias, a_log, d_skip, ssm_norm_w, w_out, norm2_w, w_up, w_down):
    Bsz, L, _ = x.shape
    xn = rms_norm(x, norm1_w)
    proj = jnp.einsum("bld,de->ble", xn, w_in)
    q, k, v, z, xbc, dt_raw = jnp.split(proj, SPLITS, axis=-1)
    q = q.reshape(Bsz, L, SB_HEADS, SB_HEAD_DIM)
    k = k.reshape(Bsz, L, SB_HEADS, SB_HEAD_DIM)
    v = v.reshape(Bsz, L, SB_HEADS, SB_HEAD_DIM)
    if k_past is None:
        k_all, v_all, q0 = k, v, 0
    else:
        k_all = jnp.concatenate([k_past.astype(k.dtype), k], axis=1)
        v_all = jnp.concatenate([v_past.astype(v.dtype), v], axis=1)
        q0 = k_past.shape[1]
    q_pos = q0 + jnp.arange(L)
    if L > SB_BLOCK and L % SB_BLOCK == 0:
        nblk = L // SB_BLOCK
        qb = q.reshape(Bsz, nblk, SB_BLOCK, SB_HEADS, SB_HEAD_DIM).swapaxes(0, 1)
        pb = q_pos.reshape(nblk, SB_BLOCK)
        o = lax.map(lambda qp: stick_breaking_block(qp[0], k_all, v_all, qp[1]), (qb, pb))
        o = o.swapaxes(0, 1).reshape(Bsz, L, SB_WIDTH)
    else:
        o = stick_breaking_block(q, k_all, v_all, q_pos).reshape(Bsz, L, SB_WIDTH)
    y_ssm, new_buf, h_final = mamba2_mixer(z, xbc, dt_raw, conv_buf, h0, conv_w, conv_b,
                                           dt_bias, a_log, d_skip, ssm_norm_w)
    mix = jnp.concatenate([o.astype(x.dtype), y_ssm], axis=-1)
    x = x + jnp.einsum("ble,ed->bld", mix, w_out)
    hn = rms_norm(x, norm2_w)
    u = jnp.square(jax.nn.relu(jnp.einsum("bld,df->blf", hn, w_up)))
    x = x + jnp.einsum("blf,fd->bld", u, w_down)
    return x, k, v, new_buf, h_final


def setup_inputs(seed: int = 0) -> dict:
    key = jax.random.key(seed)
    ks = jax.random.split(key, 24)
    f32 = jnp.float32

    def nrm(k, shape, scale=1.0):
        return jax.random.normal(k, shape, f32) * scale

    dt0 = jnp.exp(jax.random.uniform(ks[10], (DEPTH, SSM_HEADS), f32,
                                     math.log(1e-3), math.log(1e-1)))
    return {
        "x_prompt": nrm(ks[0], (BATCH, SEQ, D_MODEL)),
        "x_sample": nrm(ks[1], (DEC_BATCH, DEC_SEQ, D_MODEL)),
        "cache_k": nrm(ks[2], (DEPTH, DEC_BATCH, PAST_LEN, SB_HEADS, SB_HEAD_DIM)),
        "cache_v": nrm(ks[3], (DEPTH, DEC_BATCH, PAST_LEN, SB_HEADS, SB_HEAD_DIM)),
        "state_conv": nrm(ks[4], (DEPTH, DEC_BATCH, CONV_WIDTH - 1, CONV_CH)),
        "state_ssm": nrm(ks[5], (DEPTH, DEC_BATCH, SSM_HEADS, SSM_HEAD_DIM, SSM_STATE), 0.5),
        "norm1_w": 1.0 + nrm(ks[6], (DEPTH, D_MODEL), 0.02),
        "w_in": nrm(ks[7], (DEPTH, D_MODEL, IN_PROJ), D_MODEL ** -0.5),
        "conv_w": nrm(ks[8], (DEPTH, CONV_WIDTH, CONV_CH), CONV_WIDTH ** -0.5),
        "conv_b": nrm(ks[9], (DEPTH, CONV_CH), 0.01),
        "dt_bias": dt0 + jnp.log(-jnp.expm1(-dt0)),
        "a_log": jnp.log(jax.random.uniform(ks[11], (DEPTH, SSM_HEADS), f32, 1.0, 16.0)),
        "d_skip": 1.0 + nrm(ks[12], (DEPTH, SSM_HEADS), 0.02),
        "ssm_norm_w": 1.0 + nrm(ks[13], (DEPTH, SSM_WIDTH), 0.02),
        "w_out": nrm(ks[14], (DEPTH, MIX_WIDTH, D_MODEL), MIX_WIDTH ** -0.5),
        "norm2_w": 1.0 + nrm(ks[15], (DEPTH, D_MODEL), 0.02),
        "w_up": nrm(ks[16], (DEPTH, D_MODEL, D_FF), D_MODEL ** -0.5),
        "w_down": nrm(ks[17], (DEPTH, D_FF, D_MODEL), D_FF ** -0.5),
        "final_norm_w": 1.0 + nrm(ks[18], (D_MODEL,), 0.02),
    }


def reference(x_prompt, x_sample, cache_k, cache_v, state_conv, state_ssm,
              norm1_w, w_in, conv_w, conv_b, dt_bias, a_log, d_skip, ssm_norm_w,
              w_out, norm2_w, w_up, w_down, final_norm_w):
    hp, hs = x_prompt, x_sample
    Bp = x_prompt.shape[0]
    kp_l, vp_l, cp_l, sp_l = [], [], [], []
    ks_l, vs_l, cs_l, ss_l = [], [], [], []
    for l in range(DEPTH):
        lw = (norm1_w[l], w_in[l], conv_w[l], conv_b[l], dt_bias[l], a_log[l], d_skip[l],
              ssm_norm_w[l], w_out[l], norm2_w[l], w_up[l], w_down[l])
        conv0 = jnp.zeros((Bp, CONV_WIDTH - 1, CONV_CH), x_prompt.dtype)
        h0 = jnp.zeros((Bp, SSM_HEADS, SSM_HEAD_DIM, SSM_STATE), jnp.float32)
        hp, kp, vp, cp, sp = layer_forward(hp, None, None, conv0, h0, *lw)
        hs, kk, vv, cc, ss = layer_forward(hs, cache_k[l], cache_v[l], state_conv[l],
                                           state_ssm[l], *lw)
        kp_l.append(kp); vp_l.append(vp); cp_l.append(cp); sp_l.append(sp.astype(x_prompt.dtype))
        ks_l.append(kk.astype(cache_k.dtype)); vs_l.append(vv.astype(cache_v.dtype))
        cs_l.append(cc.astype(state_conv.dtype)); ss_l.append(ss.astype(state_ssm.dtype))
    y_prompt = rms_norm(hp, final_norm_w)
    y_sample = rms_norm(hs, final_norm_w)
    k_prompt = jnp.stack(kp_l); v_prompt = jnp.stack(vp_l)
    conv_prompt = jnp.stack(cp_l); ssm_prompt = jnp.stack(sp_l)
    k_sample = jnp.stack(ks_l); v_sample = jnp.stack(vs_l)
    conv_sample = jnp.stack(cs_l); ssm_sample = jnp.stack(ss_l)
    return (y_prompt, y_sample, k_prompt, v_prompt, conv_prompt, ssm_prompt,
            k_sample, v_sample, conv_sample, ssm_sample)
```

```cpp
#include <hip/hip_runtime.h>
#include <hip/hip_cooperative_groups.h>
#include <cstdio>
#include <cstdint>
namespace pg8 {
#define PG8_LAS __attribute__((address_space(3)))
typedef unsigned short bf16_t;
typedef short bf16x8 __attribute__((ext_vector_type(8)));
typedef float f32x4 __attribute__((ext_vector_type(4)));
typedef unsigned u32x4 __attribute__((ext_vector_type(4)));
constexpr int BM = 256, BK = 64, HALF = 128, HTB = HALF * BK * 2  , STAGE_BYTES = 8 * HTB, NXCD = 8, WGM = 8;

__host__ __device__ __forceinline__ int lds_byte(int r, int c) { const int st = (r >> 4) * 2 + (c >> 5), rr = r & 15, cc = c & 31, ob = rr * 64 + cc * 2; return st * 1024 + (ob ^ (((ob >> 9) & 1) << 5)); }
__host__ __device__ __forceinline__ void stage_rc(int b, int& R, int& C) { const int st = b / 1024, sb = b % 1024, swz = sb ^ (((sb >> 9) & 1) << 5); R = (st >> 1) * 16 + swz / 64; C = (st & 1) * 32 + (swz % 64) / 2; }
__host__ __device__ __forceinline__ int perm32(int rho) { const int n = rho >> 4, i = rho & 15; return 8 * (i >> 2) + 4 * n + (i & 3); }

struct Unit { int pm, pn; };
struct Gemm { const bf16_t* A; const bf16_t* Bt; int M, N, K, ld; };

struct StaticOrder {
    int nM, nN, nwg, G, c;
    __host__ __device__ void init(int M, int N, int G_, int c_) { nM = M / BM; nN = N / BM; nwg = nM * nN; G = G_; c = c_; }
    __host__ __device__ bool next(int i, Unit& u) const {
        const long L = (long)i * G + c; if (L >= nwg) return false;
        int wgid = (int)L; { const int q = nwg / NXCD, r = nwg % NXCD, xcd = wgid % NXCD, off = wgid / NXCD; wgid = (xcd < r ? xcd * (q + 1) : r * (q + 1) + (xcd - r) * q) + off; }
        const int nig = WGM * nN, gid = wgid / nig, fm = gid * WGM, gsz = (nM - fm) < WGM ? (nM - fm) : WGM;
        u.pm = fm + ((wgid % nig) % gsz); u.pn = (wgid % nig) / gsz; return true;
    }
    __device__ __forceinline__ void a_ready(const Unit&) const {}
    __device__ __forceinline__ void done(const Unit&) const {}
};

__device__ __forceinline__ unsigned cvt_pk_bf16(float lo, float hi) { unsigned r; asm volatile("v_cvt_pk_bf16_f32 %0, %1, %2" : "=v"(r) : "v"(lo), "v"(hi)); return r; }
template <class Epi, class Sched, bool ALIGN_EPI = false, bool SP2 = false>
__device__ __forceinline__ void gemm_phase(PG8_LAS unsigned char* lds, const Gemm g, const Sched& S, const Epi& E) {
    int tid_o = threadIdx.x; asm volatile("" : "+v"(tid_o));
    const int tid = tid_o, wid = __builtin_amdgcn_readfirstlane(tid >> 6), lane = tid & 63, wr = wid >> 2, wc = wid & 3, fr = lane & 15, fq = lane >> 4;
    const int K = g.ld  , nt = g.K / BK;
    unsigned voffA[2], voffB[2];
#pragma unroll
    for (int i = 0; i < 2; ++i) { int R, C; stage_rc(tid * 16 + i * 8192, R, C); const int Rb = Epi::PERM ? ((R & ~31) + perm32(R & 31)) : R;
        voffA[i] = (unsigned)(R * K + C) * 2u; voffB[i] = (unsigned)(Rb * K + C) * 2u; }
    const size_t kstep = (size_t)(BK * 2);
    const size_t hstep = (size_t)HALF * K * 2;
    const size_t tstep = 2 * hstep;
    const unsigned ldsw = (unsigned)wid * 1024u;
    const int aoff = lds_byte(wr * 64 + fr, fq * 8), boff = lds_byte(wc * 32 + fr, fq * 8);
#define PG8_SA(b, h) (((b) * 2 + (h)) * HTB)
#define PG8_SB(b, h) ((4 + (b) * 2 + (h)) * HTB)
#define PG8_STAGE(bufoff, gbase, voff) do { _Pragma("unroll") for (int _i = 0; _i < 2; ++_i) \
        __builtin_amdgcn_global_load_lds((const unsigned*)((const char*)(gbase) + (voff)[_i]), (PG8_LAS unsigned*)(lds + (bufoff) + ldsw + _i * 8192), 16, 0, 0); } while (0)
#define PG8_LDA(dst, b, h) do { _Pragma("unroll") for (int m = 0; m < 4; ++m) _Pragma("unroll") for (int k = 0; k < 2; ++k) dst[m][k] = *(const PG8_LAS bf16x8*)(lds + PG8_SA(b, h) + aoff + m * 2048 + k * 1024); } while (0)
#define PG8_LDB(dst, b, h) do { _Pragma("unroll") for (int n = 0; n < 2; ++n) _Pragma("unroll") for (int k = 0; k < 2; ++k) dst[n][k] = *(const PG8_LAS bf16x8*)(lds + PG8_SB(b, h) + boff + n * 2048 + k * 1024); } while (0)
#define PG8_MMA(ai, bj, At, Bt) do { __builtin_amdgcn_s_setprio(1); _Pragma("unroll") for (int m = 0; m < 4; ++m) _Pragma("unroll") for (int n = 0; n < 2; ++n) _Pragma("unroll") for (int k = 0; k < 2; ++k) \
        acc[ai][bj][m][n] = __builtin_amdgcn_mfma_f32_16x16x32_bf16(Bt[n][k], At[m][k], acc[ai][bj][m][n], 0, 0, 0); __builtin_amdgcn_s_setprio(0); } while (0)
#define PG8_WAIT_V(n) asm volatile("s_waitcnt vmcnt(" #n ")" ::: "memory")
#define PG8_WAIT_L(n) asm volatile("s_waitcnt lgkmcnt(" #n ")" ::: "memory")
#define PG8_BAR __builtin_amdgcn_s_barrier()
#define PG8_SCHED __builtin_amdgcn_sched_barrier(0)
    Unit cur, nxt; int ui = 0;
    if (!S.next(0, cur)) return;
    f32x4 acc[2][2][4][2];
#pragma unroll
    for (int a = 0; a < 2; ++a)
#pragma unroll
        for (int b = 0; b < 2; ++b)
#pragma unroll
            for (int m = 0; m < 4; ++m)
#pragma unroll
                for (int n = 0; n < 2; ++n) acc[a][b][m][n] = (f32x4){0.f, 0.f, 0.f, 0.f};
    bf16x8 At[4][2], B0[2][2], B1[2][2];
    const char* cA = (const char*)g.A + (size_t)cur.pm * tstep; const char* cB = (const char*)g.Bt + (size_t)cur.pn * tstep;
    S.a_ready(cur);
    if constexpr (SP2) {
        PG8_STAGE(PG8_SB(0, 0), cB, voffB); PG8_STAGE(PG8_SB(0, 1), cB + hstep, voffB); PG8_STAGE(PG8_SA(0, 0), cA, voffA); PG8_STAGE(PG8_SA(0, 1), cA + hstep, voffA);
        if (wr == 1) PG8_BAR;
        PG8_WAIT_V(2); PG8_BAR;
        PG8_STAGE(PG8_SB(1, 0), cB + kstep, voffB); PG8_STAGE(PG8_SA(1, 0), cA + kstep, voffA); PG8_STAGE(PG8_SB(1, 1), cB + hstep + kstep, voffB);
        PG8_WAIT_V(6); PG8_BAR;
    } else {
        PG8_STAGE(PG8_SB(0, 0), cB, voffB); PG8_STAGE(PG8_SA(0, 0), cA, voffA); PG8_STAGE(PG8_SB(0, 1), cB + hstep, voffB); PG8_STAGE(PG8_SA(0, 1), cA + hstep, voffA);
        if (wr == 1) PG8_BAR;
        PG8_WAIT_V(4); PG8_BAR;
        PG8_STAGE(PG8_SB(1, 0), cB + kstep, voffB); PG8_STAGE(PG8_SA(1, 0), cA + kstep, voffA); PG8_STAGE(PG8_SB(1, 1), cB + hstep + kstep, voffB);
        PG8_WAIT_V(6); PG8_BAR;
    }
    for (;;) {
        const bool has_next = S.next(ui + 1, nxt);
        const char* nA = has_next ? (const char*)g.A + (size_t)nxt.pm * tstep : cA; const char* nB = has_next ? (const char*)g.Bt + (size_t)nxt.pn * tstep : cB;
        for (int t = 0; t < nt; t += 2) {
            const bool last = (t == nt - 2);
            const char* a1 = cA + (size_t)(t + 1) * kstep;
            const char* a2 = last ? nA : cA + (size_t)(t + 2) * kstep; const char* b2 = last ? nB : cB + (size_t)(t + 2) * kstep;
            const char* a3 = a2 + kstep; const char* b3 = b2 + kstep;
            if (last && has_next) S.a_ready(nxt);
            if constexpr (SP2) {
            PG8_LDB(B0, 0, 0); PG8_LDB(B1, 0, 1); PG8_SCHED; PG8_LDA(At, 0, 0); PG8_STAGE(PG8_SA(1, 1), a1 + hstep, voffA);
            PG8_WAIT_V(8); PG8_WAIT_L(0); PG8_BAR; PG8_MMA(0, 0, At, B0); PG8_MMA(0, 1, At, B1); PG8_BAR; PG8_SCHED;
            PG8_LDA(At, 0, 1); PG8_STAGE(PG8_SB(0, 0), b2, voffB); PG8_STAGE(PG8_SB(0, 1), b2 + hstep, voffB); PG8_STAGE(PG8_SA(0, 0), a2, voffA);
            PG8_WAIT_V(8); PG8_WAIT_L(0); PG8_BAR; PG8_MMA(1, 0, At, B0); PG8_MMA(1, 1, At, B1); PG8_BAR; PG8_SCHED;
            PG8_LDB(B0, 1, 0); PG8_LDB(B1, 1, 1); PG8_SCHED; PG8_LDA(At, 1, 0); PG8_STAGE(PG8_SA(0, 1), a2 + hstep, voffA);
            PG8_WAIT_V(8); PG8_WAIT_L(0); PG8_BAR; PG8_MMA(0, 0, At, B0); PG8_MMA(0, 1, At, B1); PG8_BAR; PG8_SCHED;
            PG8_LDA(At, 1, 1); PG8_STAGE(PG8_SB(1, 0), b3, voffB); PG8_STAGE(PG8_SB(1, 1), b3 + hstep, voffB); PG8_STAGE(PG8_SA(1, 0), a3, voffA);
            PG8_WAIT_V(8); PG8_WAIT_L(0); PG8_BAR; PG8_MMA(1, 0, At, B0); PG8_MMA(1, 1, At, B1); PG8_BAR; PG8_SCHED;
            } else {
            PG8_LDB(B0, 0, 0); PG8_SCHED; PG8_LDA(At, 0, 0); PG8_STAGE(PG8_SA(1, 1), a1 + hstep, voffA);
            PG8_WAIT_L(8); PG8_BAR; PG8_WAIT_L(0); PG8_MMA(0, 0, At, B0); PG8_BAR; PG8_SCHED;
            PG8_LDB(B1, 0, 1); PG8_STAGE(PG8_SB(0, 0), b2, voffB);
            PG8_BAR; PG8_WAIT_L(0); PG8_MMA(0, 1, At, B1); PG8_BAR;
            PG8_LDA(At, 0, 1); PG8_STAGE(PG8_SA(0, 0), a2, voffA);
            PG8_BAR; PG8_WAIT_L(0); PG8_MMA(1, 0, At, B0); PG8_BAR; PG8_SCHED;
            PG8_STAGE(PG8_SB(0, 1), b2 + hstep, voffB);
            PG8_WAIT_V(6); PG8_BAR; PG8_MMA(1, 1, At, B1); PG8_BAR;
            PG8_LDB(B0, 1, 0); PG8_SCHED; PG8_LDA(At, 1, 0); PG8_STAGE(PG8_SA(0, 1), a2 + hstep, voffA);
            PG8_WAIT_L(8); PG8_BAR; PG8_WAIT_L(0); PG8_MMA(0, 0, At, B0); PG8_BAR; PG8_SCHED;
            PG8_LDB(B1, 1, 1); PG8_STAGE(PG8_SB(1, 0), b3, voffB);
            PG8_BAR; PG8_WAIT_L(0); PG8_MMA(0, 1, At, B1); PG8_BAR;
            PG8_LDA(At, 1, 1); PG8_STAGE(PG8_SA(1, 0), a3, voffA);
            PG8_BAR; PG8_WAIT_L(0); PG8_MMA(1, 0, At, B0); PG8_BAR; PG8_SCHED;
            PG8_STAGE(PG8_SB(1, 1), b3 + hstep, voffB);
            PG8_WAIT_V(6); PG8_BAR; PG8_MMA(1, 1, At, B1); PG8_BAR;
            }
        }
        if constexpr (ALIGN_EPI) { if (wr == 0) PG8_BAR; }
        if constexpr (!Epi::AFTER_DRAIN) { E(acc, cur, wr, wc, fr, fq); S.done(cur); }
        if (!has_next) break;
#pragma unroll
        for (int a = 0; a < 2; ++a)
#pragma unroll
            for (int b = 0; b < 2; ++b)
#pragma unroll
                for (int m = 0; m < 4; ++m)
#pragma unroll
                    for (int n = 0; n < 2; ++n) acc[a][b][m][n] = (f32x4){0.f, 0.f, 0.f, 0.f};
        cur = nxt; cA = nA; cB = nB; ++ui;
        if constexpr (ALIGN_EPI) { if (wr == 1) PG8_BAR; }
    }
    PG8_WAIT_V(0);
    if constexpr (!ALIGN_EPI) { if (wr == 0) PG8_BAR; }
    PG8_BAR;
    if constexpr (Epi::AFTER_DRAIN) { E.fused(acc, cur, wr, wc, fr, fq, lds, wid, lane); S.done(cur); }
#undef PG8_SA
#undef PG8_SB
#undef PG8_STAGE
#undef PG8_LDA
#undef PG8_LDB
#undef PG8_MMA
#undef PG8_WAIT_V
#undef PG8_WAIT_L
#undef PG8_BAR
#undef PG8_SCHED
}
}

namespace cg = cooperative_groups;
using pg8::bf16_t; using pg8::bf16x8; using pg8::f32x4; using pg8::u32x4;
typedef float f32x16 __attribute__((ext_vector_type(16)));
typedef unsigned u32x2 __attribute__((ext_vector_type(2)));
typedef float f32x2 __attribute__((ext_vector_type(2)));
#define LAS __attribute__((address_space(3)))

constexpr int DM = 1024, NPR = 65536, NSM = 2048, MTOK = NPR + NSM;
constexpr int NPROJ = 2816, INPROJ = 2824, DFF = 4096;
constexpr float EPS = 1e-5f;
constexpr float LOG2E = 1.4426950408889634f;
constexpr float QSCALE = -0.125f * LOG2E;
constexpr size_t O_Y = 0, O_KP = 69206016, O_VP = 102760448, O_CP = 136314880, O_SP = 136388608, O_KS = 137437184, O_VS = 138485760, O_CS = 139534336, O_SS = 139608064, O_END = 140656640;
constexpr size_t MiB = 1u << 20;
constexpr size_t WS_CTL = 0, WS_RSTD1 = 1 * MiB, WS_SSQ2 = 1 * MiB + 512 * 1024, WS_DTRAW = 3 * MiB, WS_WIN = 6 * MiB, WS_WOUT = 12 * MiB, WS_WUP = 14 * MiB, WS_WDN = 22 * MiB,
                 WS_KS = 30 * MiB, WS_VTS = 64 * MiB, WS_VTP = 98 * MiB, WS_MIX = 162 * MiB, WS_HB = 294 * MiB, WS_XB = 426 * MiB, WS_Q = 558 * MiB, WS_K = 624 * MiB, WS_Z = 690 * MiB,
                 WS_XBC = 756 * MiB, WS_U = 426 * MiB, WS_SBUF = 954 * MiB  , WS_LAM = 2 * MiB + 512 * 1024, WS_PART = 162 * MiB  , WS_END = 986 * MiB;
constexpr int RING_BYTES = 131072, VSTG_OFF = RING_BYTES, VSTG_WAVE = 2304, QSLOT_OFF = 159232, LDS_BYTES = 159744;
constexpr int NWAVES = 8, NTHR = 512;
constexpr int CW_BAR = 4096;
#define XCD_BAR_WORDS 3456

struct Args { const float* in[19]; float* out; unsigned char* ws; };

__device__ __forceinline__ unsigned cvt2(float lo, float hi) { return pg8::cvt_pk_bf16(lo, hi); }
__device__ __forceinline__ float bf_lo(unsigned w) { return __uint_as_float(w << 16); }
__device__ __forceinline__ float bf_hi(unsigned w) { return __uint_as_float(w & 0xffff0000u); }
__device__ __forceinline__ int crow(int r, int hi) { return (r & 3) + 8 * (r >> 2) + 4 * hi; }
__device__ __forceinline__ int pi32(int m) { return (m & 3) + 4 * (m >> 3) + 16 * ((m >> 2) & 1); }
__device__ __forceinline__ float wave_sum(float v) {
#pragma unroll
    for (int o = 1; o < 64; o <<= 1) v += __shfl_xor(v, o);
    return v;
}
__device__ __forceinline__ f32x16 mfma32(bf16x8 a, bf16x8 b, f32x16 c) { return __builtin_amdgcn_mfma_f32_32x32x16_bf16(a, b, c, 0, 0, 0); }

__device__ __forceinline__ u32x4 qt_swap(LAS u32x4* slot, u32x4 w, int fr, int fq, int lane) { slot[4 * fr + fq] = w; return slot[lane]; }
__device__ __forceinline__ u32x4 qt_unswap(LAS u32x4* slot, u32x4 w, int fr, int fq, int lane) { slot[lane] = w; return slot[4 * fr + fq]; }
struct EpiInProj {
    static constexpr bool PERM = true, AFTER_DRAIN = false;
    const float* rstd; float* out; unsigned char* ws; LAS unsigned char* lds;
    __device__ __forceinline__ void operator()(const f32x4 (&acc)[2][2][4][2], const pg8::Unit& u, int wr, int wc, int fr, int fq) const {
        const int pn = u.pn; const bool smp = u.pm >= 256;
        const int rbase = u.pm * 256 + wr * 64 + fr, cw = wc * 32 + 8 * fq;
        bf16_t* dst; int ldc, col0; float sc = 1.f; float* fo = nullptr;
        if (pn < 2) { dst = (bf16_t*)(ws + WS_Q); ldc = 512; col0 = pn * 256; sc = QSCALE; }
        else if (pn < 4) { dst = (bf16_t*)(ws + WS_K); ldc = 512; col0 = (pn - 2) * 256; fo = out + (smp ? O_KS : O_KP); }
        else if (pn < 6) { dst = nullptr; ldc = 512; col0 = (pn - 4) * 256; fo = out + (smp ? O_VS : O_VP); }
        else if (pn < 8) { dst = (bf16_t*)(ws + WS_Z); ldc = 512; col0 = (pn - 6) * 256; }
        else { dst = (bf16_t*)(ws + WS_XBC); ldc = 768; col0 = (pn - 8) * 256; }
        const bool isK = (pn == 2 || pn == 3), isV = (pn == 4 || pn == 5);
        const int lane = fr + 16 * fq, r4 = lane >> 2, c4 = lane & 3, r8 = lane >> 3, c8 = lane & 7;
        LAS u32x4* slot = (LAS u32x4*)(lds + VSTG_OFF + (wr * 4 + wc) * 3072);
        const int Rb = u.pm * 256 + wr * 64;
        float rs8[2][4];
#pragma unroll
        for (int ai = 0; ai < 2; ++ai)
#pragma unroll
            for (int m = 0; m < 4; ++m) rs8[ai][m] = rstd[rbase + ai * 128 + m * 16];
#pragma unroll
        for (int ai = 0; ai < 2; ++ai)
#pragma unroll
            for (int m = 0; m < 4; ++m) { const int Rg = Rb + ai * 128 + m * 16; const float s = rs8[ai][m] * sc;
                const int rowp = Rg + r4;
                size_t brow = (size_t)rowp;
                if (isK && smp) { const int rr = rowp - NPR; brow = (size_t)(rr >> 6) * 1088 + 1024 + (rr & 63); dst = (bf16_t*)(ws + WS_KS); }
                const size_t frA = (size_t)(smp ? Rg - NPR : Rg) + r8;
#pragma unroll
                for (int bj = 0; bj < 2; ++bj) { const int c = col0 + bj * 128 + wc * 32; const f32x4 v0 = acc[ai][bj][m][0] * s, v1 = acc[ai][bj][m][1] * s;
                    if (fo) { slot[8 * fr + 2 * fq] = __builtin_bit_cast(u32x4, v0); slot[8 * fr + 2 * fq + 1] = __builtin_bit_cast(u32x4, v1);
                        const u32x4 pa_ = slot[lane], pb_ = slot[64 + lane];
                        *(u32x4*)(fo + frA * 512 + c + 4 * c8) = pa_; *(u32x4*)(fo + (frA + 8) * 512 + c + 4 * c8) = pb_; }
                    if (!isV) { f32x4 y0 = v0, y1 = v1;
                        if (pn == 6 || pn == 7) {
#pragma unroll
                            for (int e = 0; e < 4; ++e) { y0[e] = y0[e] * __builtin_amdgcn_rcpf(1.f + __builtin_amdgcn_exp2f(-y0[e] * LOG2E)); y1[e] = y1[e] * __builtin_amdgcn_rcpf(1.f + __builtin_amdgcn_exp2f(-y1[e] * LOG2E)); } }
                        u32x4 w; w.x = cvt2(y0[0], y0[1]); w.y = cvt2(y0[2], y0[3]); w.z = cvt2(y1[0], y1[1]); w.w = cvt2(y1[2], y1[3]);
                        *(u32x4*)(dst + brow * ldc + c + 8 * c4) = qt_swap(slot + 128, w, fr, fq, lane); } }
                asm volatile("" ::: "memory"); }
        if (isV) {
            const int wid = wr * 4 + wc;
            LAS unsigned short* stg = (LAS unsigned short*)(lds + VSTG_OFF + wid * 3072);
#pragma unroll
            for (int ai = 0; ai < 2; ++ai) {
                float rs[4];
#pragma unroll
                for (int m = 0; m < 4; ++m) rs[m] = rs8[ai][m];
                const int R0 = u.pm * 256 + ai * 128 + wr * 64;
                bf16_t* vbase = !smp ? (bf16_t*)(ws + WS_VTP) + ((size_t)((R0 >> 11) * 512)) * 2048 + (R0 & 2047)
                                     : (bf16_t*)(ws + WS_VTS) + ((size_t)(((R0 - NPR) >> 6) * 512)) * 1088 + 1024;
                const int vpitch = smp ? 1088 : 2048;
#pragma unroll
                for (int bj = 0; bj < 2; ++bj)
#pragma unroll
                    for (int n = 0; n < 2; ++n) {
#pragma unroll
                        for (int m = 0; m < 4; ++m) { const f32x4 v = acc[ai][bj][m][n] * rs[m];
                            const unsigned w01 = cvt2(v[0], v[1]), w23 = cvt2(v[2], v[3]);
                            stg[(4 * fq + 0) * 72 + 16 * m + fr] = (unsigned short)(w01 & 0xffffu); stg[(4 * fq + 1) * 72 + 16 * m + fr] = (unsigned short)(w01 >> 16);
                            stg[(4 * fq + 2) * 72 + 16 * m + fr] = (unsigned short)(w23 & 0xffffu); stg[(4 * fq + 3) * 72 + 16 * m + fr] = (unsigned short)(w23 >> 16); }
                        asm volatile("s_waitcnt lgkmcnt(0)" ::: "memory");
#pragma unroll
                        for (int i = 0; i < 2; ++i) { const int piece = i * 64 + lane, ci = piece >> 3, ch = piece & 7;
                            const u32x4 v = *(const LAS u32x4*)(stg + ci * 72 + 8 * ch);
                            const int vcol = col0 + bj * 128 + wc * 32 + 8 * (ci >> 2) + 4 * n + (ci & 3);
                            *(u32x4*)(vbase + (size_t)vcol * vpitch + 8 * ch) = v; }
                        asm volatile("s_waitcnt lgkmcnt(0)" ::: "memory");
                    }
            }
        }
    }
};

struct EpiOutProj {
    static constexpr bool PERM = true, AFTER_DRAIN = false;
    const bf16_t* XB; bf16_t* HB; float* ssq; LAS unsigned char* lds;
    __device__ __forceinline__ void operator()(const f32x4 (&acc)[2][2][4][2], const pg8::Unit& u, int wr, int wc, int fr, int fq) const {
        const int rbase = u.pm * 256 + wr * 64 + fr, lane = fr + 16 * fq;
        LAS u32x4* slot = (LAS u32x4*)(lds + VSTG_OFF + (wr * 4 + wc) * 3072);
        const size_t poff = (size_t)(u.pm * 256 + wr * 64 + (lane >> 2)) * DM + u.pn * 256 + wc * 32 + 8 * (lane & 3);
        const bf16_t* xb = XB + poff; bf16_t* hb = HB + poff;
        u32x4 pre[8][2];
#pragma unroll
        for (int g = 0; g < 8; ++g) { const bf16_t* p_ = xb + (size_t)((g >> 2) * 128 + (g & 3) * 16) * DM; pre[g][0] = *(const u32x4*)p_; pre[g][1] = *(const u32x4*)(p_ + 128); }
#pragma unroll
        for (int g = 0; g < 8; ++g) { const int ai = g >> 2, m = g & 3; const int row = rbase + ai * 128 + m * 16;
            bf16_t* hr = hb + (size_t)(ai * 128 + m * 16) * DM; float s = 0.f;
#pragma unroll
            for (int bj = 0; bj < 2; ++bj) { const u32x4 r = qt_unswap(slot + ((2 * g + bj) % 3) * 64, pre[g][bj], fr, fq, lane);
                const f32x4 h0 = (f32x4){bf_lo(r.x), bf_hi(r.x), bf_lo(r.y), bf_hi(r.y)} + acc[ai][bj][m][0], h1 = (f32x4){bf_lo(r.z), bf_hi(r.z), bf_lo(r.w), bf_hi(r.w)} + acc[ai][bj][m][1];
                u32x4 w; w.x = cvt2(h0[0], h0[1]); w.y = cvt2(h0[2], h0[3]); w.z = cvt2(h1[0], h1[1]); w.w = cvt2(h1[2], h1[3]);
                *(u32x4*)(hr + bj * 128) = qt_swap(slot + ((2 * g + bj + 1) % 3) * 64, w, fr, fq, lane);
                s += (h0[0] * h0[0] + h0[1] * h0[1]) + (h0[2] * h0[2] + h0[3] * h0[3]) + (h1[0] * h1[0] + h1[1] * h1[1]) + (h1[2] * h1[2] + h1[3] * h1[3]); }
            s += __shfl_xor(s, 16); s += __shfl_xor(s, 32);
            if (fq == 0) __hip_atomic_fetch_add(ssq + row, s, __ATOMIC_RELAXED, __HIP_MEMORY_SCOPE_AGENT); }
    }
};

struct EpiUp {
    static constexpr bool PERM = true, AFTER_DRAIN = false;
    const float* ssq; bf16_t* U; LAS unsigned char* lds;
    __device__ __forceinline__ void operator()(const f32x4 (&acc)[2][2][4][2], const pg8::Unit& u, int wr, int wc, int fr, int fq) const {
        const int rbase = u.pm * 256 + wr * 64 + fr, lane = fr + 16 * fq;
        LAS u32x4* slot = (LAS u32x4*)(lds + VSTG_OFF + (wr * 4 + wc) * 3072);
        bf16_t* ub = U + (size_t)(u.pm * 256 + wr * 64 + (lane >> 2)) * DFF + u.pn * 256 + wc * 32 + 8 * (lane & 3);
        float q8[2][4];
#pragma unroll
        for (int ai = 0; ai < 2; ++ai)
#pragma unroll
            for (int m = 0; m < 4; ++m) q8[ai][m] = ssq[rbase + ai * 128 + m * 16];
#pragma unroll
        for (int ai = 0; ai < 2; ++ai)
#pragma unroll
            for (int m = 0; m < 4; ++m) { const float s = rsqrtf(q8[ai][m] * (1.0f / DM) + EPS); bf16_t* rp = ub + (size_t)(ai * 128 + m * 16) * DFF;
#pragma unroll
                for (int bj = 0; bj < 2; ++bj) { f32x4 v0 = acc[ai][bj][m][0] * s, v1 = acc[ai][bj][m][1] * s;
#pragma unroll
                    for (int e = 0; e < 4; ++e) { v0[e] = fmaxf(v0[e], 0.f); v1[e] = fmaxf(v1[e], 0.f); }
                    v0 = v0 * v0; v1 = v1 * v1;
                    u32x4 w; w.x = cvt2(v0[0], v0[1]); w.y = cvt2(v0[2], v0[3]); w.z = cvt2(v1[0], v1[1]); w.w = cvt2(v1[2], v1[3]);
                    *(u32x4*)(rp + bj * 128) = qt_swap(slot + (2 * m + bj) % 3 * 64, w, fr, fq, lane); } }
    }
};

struct EpiDown {
    static constexpr bool PERM = true, AFTER_DRAIN = false;
    bf16_t* HB; LAS unsigned char* lds;
    __device__ __forceinline__ void operator()(const f32x4 (&acc)[2][2][4][2], const pg8::Unit& u, int wr, int wc, int fr, int fq) const {
        const int lane = fr + 16 * fq;
        LAS u32x4* slot = (LAS u32x4*)(lds + VSTG_OFF + (wr * 4 + wc) * 3072);
        bf16_t* hb = HB + (size_t)(u.pm * 256 + wr * 64 + (lane >> 2)) * DM + u.pn * 256 + wc * 32 + 8 * (lane & 3);
        u32x4 pre[8][2];
#pragma unroll
        for (int g = 0; g < 8; ++g) { const bf16_t* p_ = hb + (size_t)((g >> 2) * 128 + (g & 3) * 16) * DM; pre[g][0] = *(const u32x4*)p_; pre[g][1] = *(const u32x4*)(p_ + 128); }
#pragma unroll
        for (int g = 0; g < 8; ++g) { const int ai = g >> 2, m = g & 3; bf16_t* hr = hb + (size_t)(ai * 128 + m * 16) * DM;
#pragma unroll
            for (int bj = 0; bj < 2; ++bj) { const u32x4 r = qt_unswap(slot + ((2 * g + bj) % 3) * 64, pre[g][bj], fr, fq, lane); const f32x4 a0 = acc[ai][bj][m][0], a1 = acc[ai][bj][m][1];
                u32x4 w; w.x = cvt2(bf_lo(r.x) + a0[0], bf_hi(r.x) + a0[1]); w.y = cvt2(bf_lo(r.y) + a0[2], bf_hi(r.y) + a0[3]); w.z = cvt2(bf_lo(r.z) + a1[0], bf_hi(r.z) + a1[1]); w.w = cvt2(bf_lo(r.w) + a1[2], bf_hi(r.w) + a1[3]);
                *(u32x4*)(hr + bj * 128) = qt_swap(slot + ((2 * g + bj + 1) % 3) * 64, w, fr, fq, lane); } }
    }
};
struct EpiDownPart {
    static constexpr bool PERM = true, AFTER_DRAIN = false;
    float* P;
    __device__ __forceinline__ void operator()(const f32x4 (&acc)[2][2][4][2], const pg8::Unit& u, int wr, int wc, int fr, int fq) const {
        const int rbase = (u.pm - 256) * 256 + wr * 64 + fr, cw = u.pn * 256 + wc * 32 + 8 * fq;
#pragma unroll
        for (int ai = 0; ai < 2; ++ai)
#pragma unroll
            for (int m = 0; m < 4; ++m) { float* pr = P + (size_t)(rbase + ai * 128 + m * 16) * DM + cw;
#pragma unroll
                for (int bj = 0; bj < 2; ++bj) { *(f32x4*)(pr + bj * 128) = acc[ai][bj][m][0]; *(f32x4*)(pr + bj * 128 + 4) = acc[ai][bj][m][1]; } }
    }
};
struct TailOrder {
    int pm, pn;
    __device__ bool next(int i, pg8::Unit& u) const { if (i > 0) return false; u.pm = pm; u.pn = pn; return true; }
    __device__ __forceinline__ void a_ready(const pg8::Unit&) const {}
    __device__ __forceinline__ void done(const pg8::Unit&) const {}
};
struct TailAll {
    int G, c;
    __device__ void init(int G_, int c_) { G = G_; c = c_; }
    __device__ bool next(int i, pg8::Unit& u) const { const int L = i * G + c; if (L >= 32) return false; u.pm = 256 + (L >> 2); u.pn = L & 3; return true; }
    __device__ __forceinline__ void a_ready(const pg8::Unit&) const {}
    __device__ __forceinline__ void done(const pg8::Unit&) const {}
};

struct TItem { const float* W; const float* ksc; bf16_t* WT; int ldw, ldt, k0, n0; };
__device__ __forceinline__ void titem_load(const TItem& t, f32x4 (&v)[8], int lane) {
#pragma unroll
    for (int i = 0; i < 8; ++i) { const int kk = 8 * i + (lane >> 3); v[i] = *(const f32x4*)(t.W + (size_t)(t.k0 + kk) * t.ldw + t.n0 + 4 * (lane & 7)); }
}
__device__ __forceinline__ void titem_finish(const TItem& t, const f32x4 (&v)[8], LAS float* scr, int lane) {
#pragma unroll
    for (int i = 0; i < 8; ++i) { const int kk = 8 * i + (lane >> 3); f32x4 x = v[i]; if (t.ksc) x = x * t.ksc[t.k0 + kk]; LAS float* d = scr + kk * 33 + 4 * (lane & 7); d[0] = x[0]; d[1] = x[1]; d[2] = x[2]; d[3] = x[3]; }
    asm volatile("s_waitcnt lgkmcnt(0)" ::: "memory");
    const int c = lane & 7;
#pragma unroll
    for (int j = 0; j < 4; ++j) { const int n = (lane >> 3) + 8 * j; const LAS float* s = scr + (8 * c) * 33 + n;
        u32x4 o; o.x = cvt2(s[0 * 33], s[1 * 33]); o.y = cvt2(s[2 * 33], s[3 * 33]); o.z = cvt2(s[4 * 33], s[5 * 33]); o.w = cvt2(s[6 * 33], s[7 * 33]);
        *(u32x4*)(t.WT + (size_t)(t.n0 + n) * t.ldt + t.k0 + 8 * c) = o; }
    asm volatile("s_waitcnt lgkmcnt(0)" ::: "memory");
}
constexpr int I_IN = 16 * 88, I_OUT = 16 * 32, I_UP = 16 * 128, I_DN = 64 * 32, NIT = I_IN + I_OUT + I_UP + I_DN;
__device__ __forceinline__ TItem titem_decode(const Args& a, int it) {
    unsigned char* ws = a.ws; int r = it; TItem t;
    if (r < I_IN) { t = TItem{a.in[7], a.in[6], (bf16_t*)(ws + WS_WIN), INPROJ, 1024, 64 * (r / 88), 32 * (r % 88)}; return t; } r -= I_IN;
    if (r < I_OUT) { t = TItem{a.in[14], nullptr, (bf16_t*)(ws + WS_WOUT), 1024, 1024, 64 * (r / 32), 32 * (r % 32)}; return t; } r -= I_OUT;
    if (r < I_UP) { t = TItem{a.in[16], a.in[15], (bf16_t*)(ws + WS_WUP), 4096, 1024, 64 * (r / 128), 32 * (r % 128)}; return t; } r -= I_UP;
    t = TItem{a.in[17], nullptr, (bf16_t*)(ws + WS_WDN), 1024, 4096, 64 * (r / 32), 32 * (r % 32)};
    return t;
}

__device__ __forceinline__ void p0_prologue(const Args& a, LAS unsigned char* lds, int tid, int wid, int lane) {
    unsigned char* ws = a.ws;
    const int G = gridDim.x, gw = blockIdx.x * NWAVES + wid, NGW = G * NWAVES;
    const int gt = blockIdx.x * NTHR + tid, NGT = G * NTHR;
    { float* ssq = (float*)(ws + WS_SSQ2); for (int i = gt; i < MTOK; i += NGT) ssq[i] = 0.f; unsigned* ctl = (unsigned*)(ws + WS_CTL); if (gt < 64) ctl[gt] = 0u; }
    { LAS float* scr = (LAS float*)(lds + wid * 8448);
      if (gw < NIT) { TItem cur = titem_decode(a, gw); f32x4 v[8]; titem_load(cur, v, lane);
        for (int it = gw; it < NIT; it += NGW) { const int nit = it + NGW; TItem nx = cur; f32x4 vn[8];
#pragma unroll
            for (int i = 0; i < 8; ++i) vn[i] = v[i];
            { nx = titem_decode(a, nit < NIT ? nit : it); titem_load(nx, vn, lane); }
            titem_finish(cur, v, scr, lane);
            cur = nx;
#pragma unroll
            for (int i = 0; i < 8; ++i) v[i] = vn[i]; } } }
    { const float* nw = a.in[6]; const float* win = a.in[7];
      float wd[4][4][8];
#pragma unroll
      for (int j = 0; j < 4; ++j)
#pragma unroll
          for (int e = 0; e < 4; ++e) { const int k = 256 * j + 4 * lane + e; const float s = nw[k]; const f32x4 w0 = *(const f32x4*)(win + (size_t)k * INPROJ + NPROJ), w1 = *(const f32x4*)(win + (size_t)k * INPROJ + NPROJ + 4);
#pragma unroll
              for (int q = 0; q < 4; ++q) { wd[j][e][q] = w0[q] * s; wd[j][e][4 + q] = w1[q] * s; } }
      bf16_t* XB = (bf16_t*)(ws + WS_XB); float* rstd = (float*)(ws + WS_RSTD1); float* dtr = (float*)(ws + WS_DTRAW);
      f32x4 v[4], vn1[4];
#define XROW_PTR(r_) ((r_) < NPR ? a.in[0] + (size_t)(r_) * DM : a.in[1] + (size_t)((r_) - NPR) * DM)
      { const float* xr = XROW_PTR(gw);
#pragma unroll
        for (int j = 0; j < 4; ++j) v[j] = *(const f32x4*)(xr + 256 * j + 4 * lane);
        const int r1 = gw + NGW < MTOK ? gw + NGW : gw; const float* xr1 = XROW_PTR(r1);
#pragma unroll
        for (int j = 0; j < 4; ++j) vn1[j] = *(const f32x4*)(xr1 + 256 * j + 4 * lane); }
      const bool b0 = lane & 1, b1 = lane & 2, b2 = lane & 4; const int didx = ((lane & 1) << 2) | (lane & 2) | ((lane >> 2) & 1);
      for (int row = gw; row < MTOK; row += NGW) {
          const int nrow = row + 2 * NGW; f32x4 vn[4];
          { const int nr_ = nrow < MTOK ? nrow : row; const float* xr = XROW_PTR(nr_);
#pragma unroll
              for (int j = 0; j < 4; ++j) vn[j] = *(const f32x4*)(xr + 256 * j + 4 * lane); }
          float ss = 0.f; float d[8];
#pragma unroll
          for (int q = 0; q < 8; ++q) d[q] = 0.f;
#pragma unroll
          for (int j = 0; j < 4; ++j) { ss += (v[j][0] * v[j][0] + v[j][1] * v[j][1]) + (v[j][2] * v[j][2] + v[j][3] * v[j][3]);
#pragma unroll
              for (int e = 0; e < 4; ++e)
#pragma unroll
                  for (int q = 0; q < 8; ++q) d[q] += v[j][e] * wd[j][e][q]; }
          ss = wave_sum(ss);
          float c4[4], c2[2], c1;
#pragma unroll
          for (int i = 0; i < 4; ++i) { const float keep = b0 ? d[4 + i] : d[i], send = b0 ? d[i] : d[4 + i]; c4[i] = keep + __shfl_xor(send, 1); }
#pragma unroll
          for (int i = 0; i < 2; ++i) { const float keep = b1 ? c4[2 + i] : c4[i], send = b1 ? c4[i] : c4[2 + i]; c2[i] = keep + __shfl_xor(send, 2); }
          { const float keep = b2 ? c2[1] : c2[0], send = b2 ? c2[0] : c2[1]; c1 = keep + __shfl_xor(send, 4); }
          c1 += __shfl_xor(c1, 8); c1 += __shfl_xor(c1, 16); c1 += __shfl_xor(c1, 32);
          const float rs = rsqrtf(ss * (1.0f / DM) + EPS);
#pragma unroll
          for (int j = 0; j < 4; ++j) { u32x2 w; w.x = cvt2(v[j][0], v[j][1]); w.y = cvt2(v[j][2], v[j][3]); *(u32x2*)(XB + (size_t)row * DM + 256 * j + 4 * lane) = w; }
          if (lane < 8) dtr[(size_t)row * 8 + didx] = c1 * rs;
          if (lane == 0) rstd[row] = rs;
#pragma unroll
          for (int j = 0; j < 4; ++j) { v[j] = vn1[j]; vn1[j] = vn[j]; }
      } }
#undef XROW_PTR
}

__device__ __forceinline__ float sb_half(f32x16& p) {
    float run = 1.f;
#pragma unroll
    for (int r = 15; r >= 0; --r) {
        const float e = __builtin_amdgcn_exp2f(p[r]);
        const float beta = __builtin_amdgcn_rcpf(1.f + e);
        p[r] = beta * run;
        run *= (1.f - beta);
    }
    return run;
}
template <bool SMP> __device__ __forceinline__ void attn_unit(const bf16_t* Qp, const bf16_t* Kp, const bf16_t* Vtp, int vp, int qpos0, bf16_t* Op, const float* ck, const float* cv, LAS bf16_t* stg, int lane) {
    const int lr = lane & 31, hi = lane >> 5;
    bf16x8 qf[4];
#pragma unroll
    for (int d0 = 0; d0 < 4; ++d0) qf[d0] = *(const bf16x8*)(Qp + (size_t)lr * 512 + 16 * d0 + 8 * hi);
    const bf16_t* kl = Kp + (size_t)pi32(lr) * 512 + 8 * hi;
    const bf16_t* vl = Vtp + (size_t)lr * vp + 16 * hi;
    f32x16 o0, o1;
#pragma unroll
    for (int r = 0; r < 16; ++r) { o0[r] = 0.f; o1[r] = 0.f; }
    float C = 1.f; const int qpos = qpos0 + lr;
    int t = qpos0 >> 6;
    bf16x8 kf[2][4];
    const float* ckl = SMP ? ck + (size_t)pi32(lr) * 512 + 8 * hi : nullptr;
#define ATT_LOADK(tt) do { \
        if (SMP && (tt) < 16) { _Pragma("unroll") for (int sub = 0; sub < 2; ++sub) _Pragma("unroll") for (int d0 = 0; d0 < 4; ++d0) { const float* p_ = ckl + (size_t)(64 * (tt) + 32 * sub) * 512 + 16 * d0; \
                const f32x4 x0_ = *(const f32x4*)p_, x1_ = *(const f32x4*)(p_ + 4); u32x4 w_; w_.x = cvt2(x0_[0], x0_[1]); w_.y = cvt2(x0_[2], x0_[3]); w_.z = cvt2(x1_[0], x1_[1]); w_.w = cvt2(x1_[2], x1_[3]); kf[sub][d0] = __builtin_bit_cast(bf16x8, w_); } } \
        else { _Pragma("unroll") for (int sub = 0; sub < 2; ++sub) _Pragma("unroll") for (int d0 = 0; d0 < 4; ++d0) kf[sub][d0] = *(const bf16x8*)(kl + (size_t)(64 * (tt) + 32 * sub) * 512 + 16 * d0); } } while (0)
#define ATT_LOADV(dst, tt) do { _Pragma("unroll") for (int db = 0; db < 2; ++db) _Pragma("unroll") for (int ks = 0; ks < 4; ++ks) dst[db][ks] = *(const bf16x8*)(vl + (size_t)(32 * db) * vp + 64 * (tt) + (ks >> 1) * 32 + 8 * (ks & 1)); } while (0)
    bf16x8 vf[2][4];
    u32x4 sk[8], sv[8];
    const int srow = lane >> 3, sch = lane & 7;
    const bf16_t* kco = Kp + (size_t)srow * 512 + 8 * sch; const bf16_t* vco = Vtp + (size_t)srow * vp + 8 * sch;
    LAS bf16_t* KT = stg; LAS bf16_t* VT = stg + 64 * 72;
#define ATT_LOADCO(tt) do { _Pragma("unroll") for (int i = 0; i < 8; ++i) { sk[i] = *(const u32x4*)(kco + (size_t)(64 * (tt) + 8 * i) * 512); sv[i] = *(const u32x4*)(vco + (size_t)(8 * i) * vp + 64 * (tt)); } } while (0)
    if (SMP) ATT_LOADK(t); else ATT_LOADCO(t);
    for (;;) {
        if (!SMP) {
#pragma unroll
            for (int i = 0; i < 8; ++i) { *(LAS u32x4*)(KT + (8 * i + srow) * 72 + 8 * sch) = sk[i]; *(LAS u32x4*)(VT + (8 * i + srow) * 72 + 8 * sch) = sv[i]; }
            const int tp_ = t > 0 ? t - 1 : 0; ATT_LOADCO(tp_);
#pragma unroll
            for (int sub = 0; sub < 2; ++sub)
#pragma unroll
                for (int d0 = 0; d0 < 4; ++d0) kf[sub][d0] = *(const LAS bf16x8*)(KT + (32 * sub + pi32(lr)) * 72 + 16 * d0 + 8 * hi);
        }
        f32x16 p0, p1;
#pragma unroll
        for (int r = 0; r < 16; ++r) { p0[r] = 0.f; p1[r] = 0.f; }
#pragma unroll
        for (int d0 = 0; d0 < 4; ++d0) { p0 = mfma32(kf[0][d0], qf[d0], p0); p1 = mfma32(kf[1][d0], qf[d0], p1); }
        const int tb = t * 64;
        const int tn_ = t > 0 ? t - 1 : 0; if (SMP) ATT_LOADK(tn_);
        if (!SMP) {
#pragma unroll
            for (int db = 0; db < 2; ++db)
#pragma unroll
                for (int ks = 0; ks < 4; ++ks) vf[db][ks] = *(const LAS bf16x8*)(VT + (32 * db + lr) * 72 + (ks >> 1) * 32 + 16 * hi + 8 * (ks & 1));
        } else if (t < 16) {
#pragma unroll
            for (int db = 0; db < 2; ++db)
#pragma unroll
                for (int ks = 0; ks < 4; ++ks) { const float* p_ = cv + (size_t)(tb + (ks >> 1) * 32 + 16 * hi + 8 * (ks & 1)) * 512 + 32 * db + lr; float x_[8];
#pragma unroll
                    for (int i = 0; i < 8; ++i) x_[i] = p_[(size_t)i * 512];
                    u32x4 w_; w_.x = cvt2(x_[0], x_[1]); w_.y = cvt2(x_[2], x_[3]); w_.z = cvt2(x_[4], x_[5]); w_.w = cvt2(x_[6], x_[7]); vf[db][ks] = __builtin_bit_cast(bf16x8, w_); }
        } else ATT_LOADV(vf, t);
        float T1 = 1.f;
        if (tb + 63 >= qpos0) {
#pragma unroll
            for (int r = 0; r < 16; ++r) { if (tb + 16 * hi + r >= qpos) p0[r] = 3.0e38f; if (tb + 32 + 16 * hi + r >= qpos) p1[r] = 3.0e38f; }
        }
        if (tb + 32 > qpos0 + 30) {
#pragma unroll
            for (int r = 0; r < 16; ++r) p1[r] = 0.f;
        } else T1 = sb_half(p1);
        const float T0 = sb_half(p0);
        const float T1o = __shfl_xor(T1, 32), T0o = __shfl_xor(T0, 32);
        const float T1hi = hi ? T1 : T1o, T1lo = hi ? T1o : T1, T0hi = hi ? T0 : T0o, T0lo = hi ? T0o : T0;
        const float M1 = hi ? C : C * T1hi;
        const float c2 = C * T1hi * T1lo;
        const float M0 = hi ? c2 : c2 * T0hi;
        C = c2 * T0hi * T0lo;
        if (C < 1.17549435e-38f) C = 0.f;
        bf16x8 pa[4];
        { u32x4 w;
          w.x = cvt2(p0[0] * M0, p0[1] * M0); w.y = cvt2(p0[2] * M0, p0[3] * M0); w.z = cvt2(p0[4] * M0, p0[5] * M0); w.w = cvt2(p0[6] * M0, p0[7] * M0); pa[0] = __builtin_bit_cast(bf16x8, w);
          w.x = cvt2(p0[8] * M0, p0[9] * M0); w.y = cvt2(p0[10] * M0, p0[11] * M0); w.z = cvt2(p0[12] * M0, p0[13] * M0); w.w = cvt2(p0[14] * M0, p0[15] * M0); pa[1] = __builtin_bit_cast(bf16x8, w);
          w.x = cvt2(p1[0] * M1, p1[1] * M1); w.y = cvt2(p1[2] * M1, p1[3] * M1); w.z = cvt2(p1[4] * M1, p1[5] * M1); w.w = cvt2(p1[6] * M1, p1[7] * M1); pa[2] = __builtin_bit_cast(bf16x8, w);
          w.x = cvt2(p1[8] * M1, p1[9] * M1); w.y = cvt2(p1[10] * M1, p1[11] * M1); w.z = cvt2(p1[12] * M1, p1[13] * M1); w.w = cvt2(p1[14] * M1, p1[15] * M1); pa[3] = __builtin_bit_cast(bf16x8, w); }
#pragma unroll
        for (int ks = 0; ks < 4; ++ks) { o0 = mfma32(vf[0][ks], pa[ks], o0); o1 = mfma32(vf[1][ks], pa[ks], o1); }
        if (t == 0 || __all(C == 0.f)) break;
        --t;
    }
#pragma unroll
    for (int g4 = 0; g4 < 4; ++g4) {
        u32x2 w; w.x = cvt2(o0[4 * g4], o0[4 * g4 + 1]); w.y = cvt2(o0[4 * g4 + 2], o0[4 * g4 + 3]); *(u32x2*)(Op + (size_t)lr * DM + 8 * g4 + 4 * hi) = w;
        w.x = cvt2(o1[4 * g4], o1[4 * g4 + 1]); w.y = cvt2(o1[4 * g4 + 2], o1[4 * g4 + 3]); *(u32x2*)(Op + (size_t)lr * DM + 32 + 8 * g4 + 4 * hi) = w;
    }
}
#undef ATT_LOADK
#undef ATT_LOADV
#undef ATT_LOADCO

constexpr int TP = 72, TSZ = 64 * TP * 2;
constexpr int L_CM = 0, L_BM = TSZ, L_BT = 2 * TSZ, L_XDT = 3 * TSZ, L_XDTE = 7 * TSZ, L_HT = 11 * TSZ, L_AUX = 15 * TSZ  , AUXB = 5120, L_SSQ = L_AUX + 2 * AUXB  ,
              L_CW = L_SSQ + 2048  , L_NW = L_CW + 7680  ;
static_assert(L_NW + 1024 == QSLOT_OFF, "LDS map");
__device__ __forceinline__ bf16x8 ld16(const LAS bf16_t* p) { return *(const LAS bf16x8*)p; }
__device__ __forceinline__ float silu_f(float x) { return x * __builtin_amdgcn_rcpf(1.f + __builtin_amdgcn_exp2f(-x * LOG2E)); }
__device__ __forceinline__ int ssd_gch(int lc, int g) { return lc < 256 ? g * 256 + lc : (lc < 320 ? 512 + g * 64 + (lc - 256) : 640 + g * 64 + (lc - 320)); }

__device__ __forceinline__ void ssd_item(const Args& a, LAS unsigned char* lds, int b, int g, bool smp, int sc, int mode, int tid, int wid, int lane) {
    unsigned char* ws = a.ws;
    const bf16_t* XBC = (const bf16_t*)(ws + WS_XBC); const bf16_t* Z = (const bf16_t*)(ws + WS_Z); const float* DTR = (const float*)(ws + WS_DTRAW); bf16_t* MIX = (bf16_t*)(ws + WS_MIX);
    LAS bf16_t* CM = (LAS bf16_t*)(lds + L_CM); LAS bf16_t* BM = (LAS bf16_t*)(lds + L_BM); LAS bf16_t* BT = (LAS bf16_t*)(lds + L_BT);
    LAS float* SSQ = (LAS float*)(lds + L_SSQ); LAS float* CW = (LAS float*)(lds + L_CW); LAS float* NW = (LAS float*)(lds + L_NW);
    const int nch = smp ? 1 : 4; const int tok0 = smp ? NPR + b * 64 : b * 2048 + 256 * sc; const bool full = (mode != 0), last = smp || sc == 7;
    float* SBUF = (float*)(ws + WS_SBUF); float* LAM = (float*)(ws + WS_LAM); float lam = 0.f;
    const int hh = wid >> 1, ph = wid & 1; const int head = g * 4 + hh;
#define SSD_LANE() int ln_ = lane; asm volatile("" : "+v"(ln_)); const int lr = ln_ & 31, hi = ln_ >> 5
#define AUX(buf, k) ((LAS float*)(lds + L_AUX + (buf) * AUXB + (k) * 1024))
    LAS bf16_t* XDT = (LAS bf16_t*)(lds + L_XDT + hh * TSZ); LAS bf16_t* XDTE = (LAS bf16_t*)(lds + L_XDTE + hh * TSZ); LAS bf16_t* HT = (LAS bf16_t*)(lds + L_HT + hh * TSZ);
    for (int i = tid; i < 5 * 384; i += NTHR) { const int k = i / 384, lc = i - k * 384, gch = ssd_gch(lc, g); CW[i] = k < 4 ? a.in[8][k * 768 + gch] : a.in[9][gch]; }
    if (tid < 256) NW[tid] = a.in[13][g * 256 + tid];
    float hb = 0.f, hA = 0.f, hD = 0.f; const int h4 = (tid >> 6) & 3, tt_ = tid & 63;
    if (tid < 256) { const int hd = g * 4 + h4; hb = a.in[10][hd]; hA = -__expf(a.in[11][hd]); hD = a.in[12][hd]; }
    f32x16 st[2];
    { SSD_LANE();
#pragma unroll
      for (int jn = 0; jn < 2; ++jn)
#pragma unroll
          for (int r = 0; r < 16; ++r) { float v = 0.f; if (smp) v = a.in[5][(((size_t)(b * 8 + head)) * 64 + 32 * ph + crow(r, hi)) * 64 + 32 * jn + lr]; st[jn][r] = v; }
      if (full && !smp) for (int s = 0; s < sc; ++s) { const unsigned ix = (unsigned)(((b * 2 + g) * 8 + s) * 4 + hh); const float dl = __builtin_amdgcn_exp2f(LAM[ix]); const float* sp = SBUF + (size_t)ix * 4096;
#pragma unroll
          for (int jn = 0; jn < 2; ++jn)
#pragma unroll
              for (int r = 0; r < 16; ++r) st[jn][r] = dl * st[jn][r] + sp[(32 * ph + crow(r, hi)) * 64 + 32 * jn + lr]; }
#pragma unroll
      for (int jn = 0; jn < 2; ++jn)
#pragma unroll
          for (int r = 0; r < 16; ++r) HT[(32 * ph + crow(r, hi)) * TP + 32 * jn + lr] = (bf16_t)(cvt2(st[jn][r], st[jn][r]) & 0xffffu); }
#define SSD_STEP1(buf, dtr_) do { if (tid < 256) { const float raw_ = (dtr_) + hb; const float dt_ = raw_ > 20.f ? raw_ : log1pf(__expf(raw_)); float ac_ = hA * dt_; \
        _Pragma("unroll") for (int o = 1; o < 64; o <<= 1) { const float n_ = __shfl_up(ac_, o); if (tt_ >= o) ac_ += n_; } \
        const float a63_ = __shfl(ac_, 63); const int ix_ = h4 * 64 + tt_; \
        AUX(buf, 0)[ix_] = dt_; AUX(buf, 1)[ix_] = ac_ * LOG2E; AUX(buf, 2)[ix_] = __expf(a63_ - ac_); AUX(buf, 3)[ix_] = __expf(ac_); AUX(buf, 4)[ix_] = hD * __builtin_amdgcn_rcpf(dt_); } } while (0)
    unsigned raw[3][11]; float dtr_v = 0.f; u32x2 zc[2][4];
#pragma unroll
    for (int i = 0; i < 3; ++i) { const int it = tid + NTHR * i, cp = it % 192, ts = it / 192, gch = ssd_gch(2 * cp, g); const unsigned o0 = (unsigned)((tok0 + 8 * ts - 3) * 768 + gch);
#pragma unroll
        for (int j = 3; j < 11; ++j) raw[i][j] = *(const unsigned*)(XBC + (o0 + (unsigned)(j * 768)));
#pragma unroll
        for (int j = 0; j < 3; ++j) { unsigned v = 0u;
            if (ts > 0 || sc > 0) v = *(const unsigned*)(XBC + (o0 + (unsigned)(j * 768)));
            else if (smp) { const float* sc = a.in[4] + (unsigned)((b * 3 + j) * 768 + gch); v = cvt2(sc[0], sc[1]); }
            raw[i][j] = v; }
        __builtin_amdgcn_sched_barrier(0); }
    if (tid < 256) dtr_v = DTR[(unsigned)((tok0 + tt_) * 8 + g * 4 + h4)];
    { SSD_LANE();
#pragma unroll
      for (int j = 0; j < 2; ++j)
#pragma unroll
          for (int q = 0; q < 4; ++q) { zc[j][q] = (u32x2){0u, 0u}; if (full) zc[j][q] = *(const u32x2*)(Z + (unsigned)((tok0 + 32 * j + lr) * 512 + g * 256 + hh * 64 + 32 * ph + 4 * hi + 8 * q)); } }
    SSD_STEP1(0, dtr_v);
    __syncthreads();
    for (int c = 0; c < nch; ++c) {
        const int T0 = tok0 + 64 * c, cur = c & 1; SSD_LANE(); int tl_ = tid; asm volatile("" : "+v"(tl_));
#pragma unroll
        for (int i = 0; i < 3; ++i) {
            const int it = tl_ + NTHR * i, cp = it % 192, ts = it / 192, lc = 2 * cp;
            float o0[8], o1[8];
            { float w0[5], w1[5];
#pragma unroll
              for (int k = 0; k < 5; ++k) { const f32x2 w = *(const LAS f32x2*)(CW + k * 384 + lc); w0[k] = w[0]; w1[k] = w[1]; }
#pragma unroll
              for (int tt = 0; tt < 8; ++tt) { float s0 = w0[4], s1 = w1[4];
#pragma unroll
                  for (int k = 0; k < 4; ++k) { s0 += w0[k] * bf_lo(raw[i][tt + k]); s1 += w1[k] * bf_hi(raw[i][tt + k]); }
                  o0[tt] = silu_f(s0); o1[tt] = silu_f(s1); } }
            if (full && last && c == nch - 1 && ts == 7) { float* co = a.out + (smp ? O_CS : O_CP) + (size_t)b * 3 * 768 + ssd_gch(lc, g);
#pragma unroll
                for (int j = 0; j < 3; ++j) { co[j * 768] = bf_lo(raw[i][8 + j]); co[j * 768 + 1] = bf_hi(raw[i][8 + j]); } }
            if (lc < 256) { const int h2 = lc >> 6, p = lc & 63;
                LAS bf16_t* xd = (LAS bf16_t*)(lds + L_XDT + h2 * TSZ) + p * TP + 8 * ts; LAS bf16_t* xe = (LAS bf16_t*)(lds + L_XDTE + h2 * TSZ) + p * TP + 8 * ts;
                float e0[8], e1[8];
#pragma unroll
                for (int q = 0; q < 2; ++q) { const f32x4 dt4 = *(const LAS f32x4*)(AUX(cur, 0) + h2 * 64 + 8 * ts + 4 * q), de4 = *(const LAS f32x4*)(AUX(cur, 2) + h2 * 64 + 8 * ts + 4 * q);
#pragma unroll
                    for (int e = 0; e < 4; ++e) { const int tt = 4 * q + e; o0[tt] *= dt4[e]; o1[tt] *= dt4[e]; e0[tt] = o0[tt] * de4[e]; e1[tt] = o1[tt] * de4[e]; } }
                u32x4 w; w.x = cvt2(o0[0], o0[1]); w.y = cvt2(o0[2], o0[3]); w.z = cvt2(o0[4], o0[5]); w.w = cvt2(o0[6], o0[7]); *(LAS u32x4*)xd = w;
                w.x = cvt2(o1[0], o1[1]); w.y = cvt2(o1[2], o1[3]); w.z = cvt2(o1[4], o1[5]); w.w = cvt2(o1[6], o1[7]); *(LAS u32x4*)(xd + TP) = w;
                w.x = cvt2(e0[0], e0[1]); w.y = cvt2(e0[2], e0[3]); w.z = cvt2(e0[4], e0[5]); w.w = cvt2(e0[6], e0[7]); *(LAS u32x4*)xe = w;
                w.x = cvt2(e1[0], e1[1]); w.y = cvt2(e1[2], e1[3]); w.z = cvt2(e1[4], e1[5]); w.w = cvt2(e1[6], e1[7]); *(LAS u32x4*)(xe + TP) = w;
            } else if (lc < 320) { const int n = lc - 256;
#pragma unroll
                for (int tt = 0; tt < 8; ++tt) *(LAS unsigned*)(BM + (8 * ts + tt) * TP + n) = cvt2(o0[tt], o1[tt]);
                u32x4 w; w.x = cvt2(o0[0], o0[1]); w.y = cvt2(o0[2], o0[3]); w.z = cvt2(o0[4], o0[5]); w.w = cvt2(o0[6], o0[7]); *(LAS u32x4*)(BT + n * TP + 8 * ts) = w;
                w.x = cvt2(o1[0], o1[1]); w.y = cvt2(o1[2], o1[3]); w.z = cvt2(o1[4], o1[5]); w.w = cvt2(o1[6], o1[7]); *(LAS u32x4*)(BT + (n + 1) * TP + 8 * ts) = w;
            } else { const int n = lc - 320;
#pragma unroll
                for (int tt = 0; tt < 8; ++tt) *(LAS unsigned*)(CM + (8 * ts + tt) * TP + n) = cvt2(o0[tt], o1[tt]); }
            __builtin_amdgcn_sched_barrier(0);
        }
        __syncthreads();
        { const int Tn = (c + 1 < nch) ? T0 + 64 : T0;
#pragma unroll
            for (int i = 0; i < 3; ++i) { const int it = tl_ + NTHR * i, cp = it % 192, ts = it / 192; const unsigned o0 = (unsigned)((Tn + 8 * ts - 3) * 768 + ssd_gch(2 * cp, g));
#pragma unroll
                for (int j = 0; j < 11; ++j) raw[i][j] = *(const unsigned*)(XBC + (o0 + (unsigned)(j * 768))); }
            dtr_v = DTR[(unsigned)((Tn + tt_) * 8 + g * 4 + h4)];
        }
        __builtin_amdgcn_sched_barrier(0);
        if (full) {
        f32x16 yT[2];
#pragma unroll
        for (int j = 0; j < 2; ++j) {
#pragma unroll
            for (int r = 0; r < 16; ++r) yT[j][r] = 0.f;
#pragma unroll
            for (int ks = 0; ks < 4; ++ks) yT[j] = mfma32(ld16(HT + (32 * ph + lr) * TP + 16 * ks + 8 * hi), ld16(CM + (32 * j + lr) * TP + 16 * ks + 8 * hi), yT[j]);
            const int l = 32 * j + lr; const float al = AUX(cur, 1)[hh * 64 + l], ea = AUX(cur, 3)[hh * 64 + l], dsk = AUX(cur, 4)[hh * 64 + l];
#pragma unroll
            for (int r = 0; r < 16; ++r) yT[j][r] *= ea;
            for (int sb = 0; sb <= j; ++sb) {
                f32x16 GT;
#pragma unroll
                for (int r = 0; r < 16; ++r) GT[r] = 0.f;
#pragma unroll
                for (int ks = 0; ks < 4; ++ks) GT = mfma32(ld16(BM + (32 * sb + pi32(lr)) * TP + 16 * ks + 8 * hi), ld16(CM + (32 * j + lr) * TP + 16 * ks + 8 * hi), GT);
                const LAS f32x4* as4 = (const LAS f32x4*)(AUX(cur, 1) + hh * 64 + 32 * sb + 16 * hi);
                float gv[16];
#pragma unroll
                for (int q = 0; q < 4; ++q) { const f32x4 as = as4[q];
#pragma unroll
                    for (int e = 0; e < 4; ++e) { const int r = 4 * q + e, s = 32 * sb + 16 * hi + r; const float ex = __builtin_amdgcn_exp2f(al - as[e]);
                        float v = GT[r] * ex;
                        if (sb == j) { v = (s <= l) ? v : 0.f; if (s == l) v += dsk; }
                        gv[r] = v; } }
                u32x4 w; w.x = cvt2(gv[0], gv[1]); w.y = cvt2(gv[2], gv[3]); w.z = cvt2(gv[4], gv[5]); w.w = cvt2(gv[6], gv[7]); const bf16x8 pb0 = __builtin_bit_cast(bf16x8, w);
                w.x = cvt2(gv[8], gv[9]); w.y = cvt2(gv[10], gv[11]); w.z = cvt2(gv[12], gv[13]); w.w = cvt2(gv[14], gv[15]); const bf16x8 pb1 = __builtin_bit_cast(bf16x8, w);
                yT[j] = mfma32(ld16(XDT + (32 * ph + lr) * TP + 32 * sb + 16 * hi), pb0, yT[j]);
                yT[j] = mfma32(ld16(XDT + (32 * ph + lr) * TP + 32 * sb + 16 * hi + 8), pb1, yT[j]);
            }
        }
        __builtin_amdgcn_sched_barrier(0);
#pragma unroll
        for (int j = 0; j < 2; ++j) { float ssq = 0.f;
#pragma unroll
            for (int q = 0; q < 4; ++q) { const u32x2 zw = zc[j][q]; const float z4[4] = {bf_lo(zw.x), bf_hi(zw.x), bf_lo(zw.y), bf_hi(zw.y)};
#pragma unroll
                for (int e = 0; e < 4; ++e) { const float v = yT[j][4 * q + e] * z4[e]; yT[j][4 * q + e] = v; ssq += v * v; } }
            ssq += __shfl_xor(ssq, 32);
            if (hi == 0) SSQ[wid * 64 + 32 * j + lr] = ssq; }
        __syncthreads();
        { const int Tn = (c + 1 < nch) ? T0 + 64 : T0;
#pragma unroll
            for (int j = 0; j < 2; ++j)
#pragma unroll
                for (int q = 0; q < 4; ++q) zc[j][q] = *(const u32x2*)(Z + (unsigned)((Tn + 32 * j + lr) * 512 + g * 256 + hh * 64 + 32 * ph + 4 * hi + 8 * q));
        }
#pragma unroll
        for (int j = 0; j < 2; ++j) { float tot = 0.f;
#pragma unroll
            for (int w8 = 0; w8 < 8; ++w8) tot += SSQ[w8 * 64 + 32 * j + lr];
            const float rs = rsqrtf(tot * (1.0f / 256.0f) + EPS);
            const int chl = hh * 64 + 32 * ph + 4 * hi; bf16_t* mr = MIX + (unsigned)((T0 + 32 * j + lr) * DM + 512 + g * 256 + chl);
#pragma unroll
            for (int q = 0; q < 4; ++q) { const f32x4 nw = *(const LAS f32x4*)(NW + chl + 8 * q);
                u32x2 w; w.x = cvt2(yT[j][4 * q] * rs * nw[0], yT[j][4 * q + 1] * rs * nw[1]); w.y = cvt2(yT[j][4 * q + 2] * rs * nw[2], yT[j][4 * q + 3] * rs * nw[3]); *(u32x2*)(mr + 8 * q) = w; } }
        }
        { const float dec = AUX(cur, 3)[hh * 64 + 63]; lam += AUX(cur, 1)[hh * 64 + 63];
#pragma unroll
          for (int jn = 0; jn < 2; ++jn) {
#pragma unroll
              for (int r = 0; r < 16; ++r) st[jn][r] *= dec;
#pragma unroll
              for (int ks = 0; ks < 4; ++ks) st[jn] = mfma32(ld16(XDTE + (32 * ph + lr) * TP + 16 * ks + 8 * hi), ld16(BT + (32 * jn + lr) * TP + 16 * ks + 8 * hi), st[jn]);
          }
          if (c + 1 < nch) {
              if (full) {
#pragma unroll
              for (int jn = 0; jn < 2; ++jn)
#pragma unroll
                  for (int r = 0; r < 16; ++r) HT[(32 * ph + crow(r, hi)) * TP + 32 * jn + lr] = (bf16_t)(cvt2(st[jn][r], st[jn][r]) & 0xffffu); }
              SSD_STEP1(cur ^ 1, dtr_v);
          } }
        __syncthreads();
    }
    if (!full) { SSD_LANE(); const unsigned ix = (unsigned)(((b * 2 + g) * 8 + sc) * 4 + hh); float* sp = SBUF + (size_t)ix * 4096; if (ph == 0 && ln_ == 0) LAM[ix] = lam;
#pragma unroll
      for (int jn = 0; jn < 2; ++jn)
#pragma unroll
          for (int r = 0; r < 16; ++r) sp[(32 * ph + crow(r, hi)) * 64 + 32 * jn + lr] = st[jn][r]; }
    else if (last) { SSD_LANE(); float* so = a.out + (smp ? O_SS : O_SP) + ((size_t)(b * 8 + head)) * 4096;
#pragma unroll
      for (int jn = 0; jn < 2; ++jn)
#pragma unroll
          for (int r = 0; r < 16; ++r) so[(32 * ph + crow(r, hi)) * 64 + 32 * jn + lr] = st[jn][r]; }
#undef SSD_LANE
#undef AUX
#undef SSD_STEP1
}

#define XB_TMO      128
#define XB_XCNT(j)  (256  + 64 * (j))
#define XB_XSUB(j)  (1280 + 64 * (j))
#define XB_XGEN(j)  (2304 + 64 * (j))
#define XB_TOP      3328
#define XB_TOPGEN   3392
#define XCD_BAR_WORDS 3456
#define XB_SPIN_CAP (1u << 18)

__device__ __forceinline__ unsigned xb_ld(unsigned* p)              { return __hip_atomic_load(p, __ATOMIC_RELAXED, __HIP_MEMORY_SCOPE_AGENT); }
__device__ __forceinline__ unsigned xb_add(unsigned* p, unsigned v) { return __hip_atomic_fetch_add(p, v, __ATOMIC_RELAXED, __HIP_MEMORY_SCOPE_AGENT); }
__device__ __forceinline__ unsigned xb_xcc_id() { return (unsigned)__builtin_amdgcn_s_getreg((3 << 11) | 20) & 0xFu; }
#define XB_SPIN(cond, bar) do { unsigned _sp = 0; while (cond) { __builtin_amdgcn_s_sleep(1); \
    if ((++_sp & 255u) == 0u) { if (xb_ld(&(bar)[XB_TMO])) break; if (_sp > XB_SPIN_CAP) { atomicAdd(&(bar)[XB_TMO], 1u); break; } } } } while (0)

struct XcdBarrier {
    unsigned* bar; unsigned x;
    volatile LAS unsigned* st;
};

__device__ __forceinline__ XcdBarrier xcd_barrier_post(unsigned* bar, volatile LAS unsigned* st) {
    XcdBarrier b; b.bar = bar; b.x = xb_xcc_id(); b.st = st;
    if (threadIdx.x == 0) (void)xb_add(&bar[XB_XCNT(b.x)], 1u);
    return b;
}
__device__ __forceinline__ void xcd_barrier_complete(unsigned* bar, unsigned x, unsigned& nloc, unsigned& nx) {
    const unsigned G = gridDim.x * gridDim.y * gridDim.z;
    unsigned sum, cnt, mine, sp = 0u;
    for (;;) {
        sum = 0u; cnt = 0u; mine = 0u;
#pragma unroll
        for (unsigned j = 0; j < 16; ++j) { const unsigned c = xb_ld(&bar[XB_XCNT(j)]); sum += c; cnt += (c > 0u) ? 1u : 0u; mine = (j == x) ? c : mine; }
        if (sum == G) break;
        __builtin_amdgcn_s_sleep(1);
        if ((++sp & 255u) == 0u) { if (xb_ld(&bar[XB_TMO])) break; if (sp > XB_SPIN_CAP) { atomicAdd(&bar[XB_TMO], 1u); break; } }
    }
    nloc = mine > 0u ? mine : 1u; nx = cnt > 0u ? cnt : 1u;
}

__device__ __forceinline__ void xcd_barrier(const XcdBarrier& b) {
    asm volatile("s_waitcnt vmcnt(0)" ::: "memory");
    __syncthreads();
    if (threadIdx.x == 0) {
        unsigned* bar = b.bar;
        __builtin_amdgcn_s_waitcnt(0);
        unsigned nloc = b.st[0], nx = b.st[1];
        if (nloc == 0u) { xcd_barrier_complete(bar, b.x, nloc, nx); b.st[0] = nloc; b.st[1] = nx; }
        const unsigned old = xb_add(&bar[XB_XSUB(b.x)], 1u);
        const unsigned gen = old / nloc;
        if (old + 1u == (gen + 1u) * nloc) {
            __builtin_amdgcn_fence(__ATOMIC_RELEASE, "agent");
            asm volatile("s_waitcnt vmcnt(0)" ::: "memory");
            const unsigned og = xb_add(&bar[XB_TOP], 1u);
            const unsigned tg = og / nx;
            if (og + 1u == (tg + 1u) * nx) xb_add(&bar[XB_TOPGEN], 1u);
            else XB_SPIN(xb_ld(&bar[XB_TOPGEN]) == tg, bar);
            __builtin_amdgcn_fence(__ATOMIC_ACQUIRE, "agent");
            xb_add(&bar[XB_XGEN(b.x)], 1u);
            asm volatile("s_waitcnt vmcnt(0)" ::: "memory");
        } else {
            XB_SPIN(xb_ld(&bar[XB_XGEN(b.x)]) == gen, bar);
            __builtin_amdgcn_fence(__ATOMIC_ACQUIRE, "agent");
            asm volatile("s_waitcnt vmcnt(0)" ::: "memory");
        }
    }
    __syncthreads();
}

__global__ void __launch_bounds__(NTHR, 2) hybrid_fwd(Args a) {
    extern __shared__ __attribute__((aligned(16))) unsigned char lds_raw[];
    LAS unsigned char* lds = (LAS unsigned char*)lds_raw;
    cg::grid_group grid = cg::this_grid();
    unsigned char* ws = a.ws; const int G = gridDim.x;
    if (gridDim.x == 0x7fffffffu) grid.sync();
    volatile LAS unsigned* bst = (volatile LAS unsigned*)(lds + QSLOT_OFF + 16);
    if (threadIdx.x == 0) { bst[0] = 0u; bst[1] = 0u; }
    __syncthreads();
    const XcdBarrier bar = xcd_barrier_post((unsigned*)(ws + WS_CTL) + CW_BAR, bst);
#define GRID_SYNC() xcd_barrier(bar)
#define PHASE_IDS() int tid = threadIdx.x; asm volatile("" : "+v"(tid)); const int lane = tid & 63, wid = __builtin_amdgcn_readfirstlane(tid >> 6)

#ifndef SKIP_P0
    { PHASE_IDS(); p0_prologue(a, lds, tid, wid, lane); }
#endif
    GRID_SYNC();

#ifndef SKIP_P1
    { pg8::Gemm g{(const bf16_t*)(ws + WS_XB), (const bf16_t*)(ws + WS_WIN), NPR, NPROJ, DM, DM}; pg8::StaticOrder S; S.init(NPR, NPROJ, G, (int)blockIdx.x);
      EpiInProj E{(const float*)(ws + WS_RSTD1), a.out, ws, lds};
      pg8::gemm_phase<EpiInProj, pg8::StaticOrder, true, true>(lds, g, S, E); }
#endif
    GRID_SYNC();

#ifndef SKIP_P2
    for (int sp = 0; sp < 2; ++sp)
    { const int tid_p = threadIdx.x; unsigned* ctl = (unsigned*)(ws + WS_CTL) + sp; volatile LAS unsigned* qslot = (volatile LAS unsigned*)(lds + QSLOT_OFF);
      const bf16_t* Q = (const bf16_t*)(ws + WS_Q); const bf16_t* K = (const bf16_t*)(ws + WS_K); const bf16_t* KS = (const bf16_t*)(ws + WS_KS);
      const bf16_t* VTP = (const bf16_t*)(ws + WS_VTP); const bf16_t* VTS = (const bf16_t*)(ws + WS_VTS); bf16_t* MIX = (bf16_t*)(ws + WS_MIX);
      constexpr int N_SSDA = 448, N_GEMS = 88, N_SSDS = 64, N_ATTS = 64, N_ATTP = 1024, N_ATTP_A = 704, N_SSDC = 512;
      const int nitems = sp == 0 ? N_GEMS + N_SSDA + N_ATTP_A : N_SSDC + N_SSDS + N_ATTS + (N_ATTP - N_ATTP_A);
      for (;;) {
          if (tid_p == 0) *qslot = __hip_atomic_fetch_add(ctl, 1u, __ATOMIC_RELAXED, __HIP_MEMORY_SCOPE_AGENT);
          __syncthreads();
          int item = (int)*qslot;
          __syncthreads();
          if (item >= nitems) break;
          int tid = tid_p; asm volatile("" : "+v"(tid)); const int lane = tid & 63, wid = __builtin_amdgcn_readfirstlane(tid >> 6);
          int kind, s_b = 0, s_g = 0, s_sc = 0, s_mode = 0, aidx = 0; bool s_smp = false;
          if (sp == 0) {
              if (item < N_GEMS) { kind = 3; aidx = item; }
              else if (item < N_GEMS + N_SSDA) { kind = 0; const int it2 = item - N_GEMS, bg = it2 / 7; s_sc = it2 - bg * 7; s_b = bg >> 1; s_g = bg & 1; s_mode = 0; }
              else { kind = 1; aidx = item - N_GEMS - N_SSDA; }
          } else {
              if (item < N_SSDC) { kind = 0; s_sc = item & 7; const int bg = item >> 3; s_b = bg >> 1; s_g = bg & 1; s_mode = 1; }
              else if (item < N_SSDC + N_SSDS) { kind = 0; const int bg = item - N_SSDC; s_b = bg >> 1; s_g = bg & 1; s_smp = true; s_mode = 1; }
              else if (item < N_SSDC + N_SSDS + N_ATTS) { kind = 2; aidx = item - N_SSDC - N_SSDS; }
              else { kind = 1; aidx = item - N_SSDC - N_SSDS - N_ATTS + N_ATTP_A; }
          }
          if (kind == 3) {
              pg8::Gemm g{(const bf16_t*)(ws + WS_XB), (const bf16_t*)(ws + WS_WIN), MTOK, NPROJ, DM, DM}; TailOrder S1{256 + aidx / 11, aidx % 11};
              EpiInProj E{(const float*)(ws + WS_RSTD1), a.out, ws, lds};
              pg8::gemm_phase<EpiInProj, TailOrder, true, true>(lds, g, S1, E);
              __syncthreads();
          } else if (kind == 0) {
#ifndef SKIP_SSD
              ssd_item(a, lds, s_b, s_g, s_smp, s_sc, s_mode, tid, wid, lane);
#endif
          } else {
#ifndef SKIP_ATT
              const int nu = kind == 1 ? 2 : 1;
              for (int u = 0; u < nu; ++u) {
                  int bb, hh_, q0, qpos0, vp; const bf16_t *Qp, *Kp, *Vtp; bf16_t* Op;
                  if (kind == 1) { const int bh = aidx >> 2, quarter = aidx & 3; bb = bh >> 3; hh_ = bh & 7; const int qb = 16 * quarter + (u ? 15 - wid : wid); q0 = 32 * qb; qpos0 = q0; vp = 2048;
                      Qp = Q + (size_t)(bb * 2048 + q0) * 512 + hh_ * 64; Kp = K + (size_t)(bb * 2048) * 512 + hh_ * 64; Vtp = VTP + (size_t)(bb * 512 + hh_ * 64) * 2048; Op = MIX + (size_t)(bb * 2048 + q0) * DM + hh_ * 64; }
                  else { const int id = aidx * 8 + wid, bh = id >> 1; q0 = 32 * (id & 1); bb = bh >> 3; hh_ = bh & 7; qpos0 = 1024 + q0; vp = 1088;
                      Qp = Q + (size_t)(NPR + bb * 64 + q0) * 512 + hh_ * 64; Kp = KS + (size_t)(bb * 1088) * 512 + hh_ * 64; Vtp = VTS + (size_t)(bb * 512 + hh_ * 64) * 1088; Op = MIX + (size_t)(NPR + bb * 64 + q0) * DM + hh_ * 64; }
                  LAS bf16_t* astg = (LAS bf16_t*)(lds + wid * 18432);
                  if (kind == 1) attn_unit<false>(Qp, Kp, Vtp, vp, qpos0, Op, nullptr, nullptr, astg, lane);
                  else attn_unit<true>(Qp, Kp, Vtp, vp, qpos0, Op, a.in[2] + (size_t)(bb * 1024) * 512 + hh_ * 64, a.in[3] + (size_t)(bb * 1024) * 512 + hh_ * 64, astg, lane);
              }
#endif
          }
      }
      if (sp == 0) GRID_SYNC(); }
#endif
    GRID_SYNC();

#ifndef SKIP_P3
    { pg8::Gemm g{(const bf16_t*)(ws + WS_MIX), (const bf16_t*)(ws + WS_WOUT), MTOK, DM, DM, DM}; pg8::StaticOrder S; S.init(MTOK, DM, G, (int)blockIdx.x);
      EpiOutProj E{(const bf16_t*)(ws + WS_XB), (bf16_t*)(ws + WS_HB), (float*)(ws + WS_SSQ2), lds};
      pg8::gemm_phase<EpiOutProj, pg8::StaticOrder, true, true>(lds, g, S, E); }
#endif
    GRID_SYNC();

#ifndef SKIP_P4
    { pg8::Gemm g{(const bf16_t*)(ws + WS_HB), (const bf16_t*)(ws + WS_WUP), MTOK, DFF, DM, DM}; pg8::StaticOrder S; S.init(MTOK, DFF, G, (int)blockIdx.x);
      EpiUp E{(const float*)(ws + WS_SSQ2), (bf16_t*)(ws + WS_U), lds};
      pg8::gemm_phase<EpiUp, pg8::StaticOrder, true, true>(lds, g, S, E); }
#endif
    GRID_SYNC();

#ifndef SKIP_P5
    { pg8::Gemm g{(const bf16_t*)(ws + WS_U), (const bf16_t*)(ws + WS_WDN), NPR, DM, DFF, DFF}; pg8::StaticOrder S; S.init(NPR, DM, G, (int)blockIdx.x);
      EpiDown E{(bf16_t*)(ws + WS_HB), lds};
      pg8::gemm_phase<EpiDown, pg8::StaticOrder, true, true>(lds, g, S, E);
      if (G == 256) { const int c = (int)blockIdx.x, k = c >> 3, unit = (c & 7) + 8 * (k >> 3), slice = k & 7;
          pg8::Gemm gt{(const bf16_t*)(ws + WS_U) + slice * 512, (const bf16_t*)(ws + WS_WDN) + slice * 512, MTOK, DM, 512, DFF};
          TailOrder St{256 + (unit >> 2), unit & 3}; EpiDownPart Et{(float*)(ws + WS_PART) + (size_t)slice * NSM * DM};
          pg8::gemm_phase<EpiDownPart, TailOrder, true, true>(lds, gt, St, Et); }
      else { pg8::Gemm gt{(const bf16_t*)(ws + WS_U), (const bf16_t*)(ws + WS_WDN), MTOK, DM, DFF, DFF}; TailAll St; St.init(G, (int)blockIdx.x); EpiDownPart Et{(float*)(ws + WS_PART)};
          float* pz = (float*)(ws + WS_PART) + (size_t)NSM * DM; for (size_t i = (size_t)blockIdx.x * NTHR + threadIdx.x; i < (size_t)7 * NSM * DM; i += (size_t)G * NTHR) pz[i] = 0.f;
          pg8::gemm_phase<EpiDownPart, TailAll, true, true>(lds, gt, St, Et); } }
#endif
    GRID_SYNC();

#ifndef SKIP_P6
    { PHASE_IDS(); const float* fw = a.in[18]; float* Y = a.out + O_Y; const int gw = blockIdx.x * NWAVES + wid, NGW = G * NWAVES;
      f32x4 w4[4];
#pragma unroll
      for (int j = 0; j < 4; ++j) w4[j] = *(const f32x4*)(fw + 256 * j + 4 * lane);
      const bf16_t* HBp = (const bf16_t*)(ws + WS_HB);
      u32x2 c0[4], c1[4], c2[4];
      { const int r1 = gw + NGW < MTOK ? gw + NGW : gw, r2 = gw + 2 * NGW < MTOK ? gw + 2 * NGW : gw;
#pragma unroll
        for (int j = 0; j < 4; ++j) { c0[j] = *(const u32x2*)(HBp + (size_t)gw * DM + 4 * lane + 256 * j); c1[j] = *(const u32x2*)(HBp + (size_t)r1 * DM + 4 * lane + 256 * j); c2[j] = *(const u32x2*)(HBp + (size_t)r2 * DM + 4 * lane + 256 * j); } }
      for (int row = gw; row < MTOK; row += NGW) { float* yr = Y + (size_t)row * DM + 4 * lane; const int nrow = row + 3 * NGW; u32x2 cn[4]; float ss = 0.f; f32x4 v[4];
#pragma unroll
          for (int j = 0; j < 4; ++j) cn[j] = *(const u32x2*)(HBp + (size_t)(nrow < MTOK ? nrow : row) * DM + 4 * lane + 256 * j);
#pragma unroll
          for (int j = 0; j < 4; ++j) v[j] = (f32x4){bf_lo(c0[j].x), bf_hi(c0[j].x), bf_lo(c0[j].y), bf_hi(c0[j].y)};
          if (row >= NPR) { const float* pr = (const float*)(ws + WS_PART) + (size_t)(row - NPR) * DM + 4 * lane;
              for (int sl = 0; sl < 8; ++sl)
#pragma unroll
                  for (int j = 0; j < 4; ++j) v[j] += *(const f32x4*)(pr + (size_t)sl * NSM * DM + 256 * j); }
#pragma unroll
          for (int j = 0; j < 4; ++j) ss += (v[j][0] * v[j][0] + v[j][1] * v[j][1]) + (v[j][2] * v[j][2] + v[j][3] * v[j][3]);
          const float rs = rsqrtf(wave_sum(ss) * (1.0f / DM) + EPS);
#pragma unroll
          for (int j = 0; j < 4; ++j) { *(f32x4*)(yr + 256 * j) = v[j] * rs * w4[j]; c0[j] = c1[j]; c1[j] = c2[j]; c2[j] = cn[j]; } } }
#endif
}

extern "C" void kernel_launch(void* const* d_in, const int* in_sizes, int n_in, void* d_out, int out_size, void* d_ws, size_t ws_size, hipStream_t stream) {
    static int grid = 0;
    if (grid == 0) {
        if (n_in != 19 || (size_t)out_size != O_END || ws_size < WS_END) { fprintf(stderr, "kernel_launch: unexpected shapes (n_in %d, out %d, ws %zu)\n", n_in, out_size, ws_size); grid = -1; return; }
        int dev = 0, cus = 0, per_cu = 0;
        hipGetDevice(&dev); hipDeviceGetAttribute(&cus, hipDeviceAttributeMultiprocessorCount, dev);
        if (hipFuncSetAttribute((const void*)hybrid_fwd, hipFuncAttributeMaxDynamicSharedMemorySize, LDS_BYTES) != hipSuccess) { fprintf(stderr, "kernel_launch: hipFuncSetAttribute failed\n"); grid = -1; return; }
        if (hipOccupancyMaxActiveBlocksPerMultiprocessor(&per_cu, (const void*)hybrid_fwd, NTHR, LDS_BYTES) != hipSuccess || per_cu < 1) { fprintf(stderr, "kernel_launch: occupancy query says %d\n", per_cu); per_cu = 1; }
        (void)hipGetLastError();
        grid = cus * 1;
        if (grid <= 0) grid = 256;
    }
    if (grid < 0) return;
    if (hipMemsetAsync((char*)d_ws + WS_CTL + (size_t)CW_BAR * 4, 0, (size_t)XCD_BAR_WORDS * 4, stream) != hipSuccess) { fprintf(stderr, "kernel_launch: hipMemsetAsync of the barrier words failed\n"); return; }
    Args a{};
    for (int i = 0; i < 19; ++i) a.in[i] = (const float*)d_in[i];
    a.out = (float*)d_out; a.ws = (unsigned char*)d_ws;
    void* args[] = {&a};
    hipError_t e = hipLaunchCooperativeKernel((const void*)hybrid_fwd, dim3(grid), dim3(NTHR), args, LDS_BYTES, stream);
    if (e != hipSuccess) fprintf(stderr, "cooperative launch failed: %s (grid %d)\n", hipGetErrorString(e), grid);
}
```

```cpp
#include <hip/hip_runtime.h>
#include <hip/hip_cooperative_groups.h>
#include <cstdio>
#include <cstdint>
namespace pg8 {
#define PG8_LAS __attribute__((address_space(3)))
typedef unsigned short bf16_t;
typedef short bf16x8 __attribute__((ext_vector_type(8)));
typedef float f32x4 __attribute__((ext_vector_type(4)));
typedef unsigned u32x4 __attribute__((ext_vector_type(4)));
constexpr int BM = 256, BK = 64, HALF = 128, HTB = HALF * BK * 2  , STAGE_BYTES = 8 * HTB, NXCD = 8, WGM = 8;

__host__ __device__ __forceinline__ int lds_byte(int r, int c) { const int st = (r >> 4) * 2 + (c >> 5), rr = r & 15, cc = c & 31, ob = rr * 64 + cc * 2; return st * 1024 + (ob ^ (((ob >> 9) & 1) << 5)); }
__host__ __device__ __forceinline__ void stage_rc(int b, int& R, int& C) { const int st = b / 1024, sb = b % 1024, swz = sb ^ (((sb >> 9) & 1) << 5); R = (st >> 1) * 16 + swz / 64; C = (st & 1) * 32 + (swz % 64) / 2; }
__host__ __device__ __forceinline__ int perm32(int rho) { const int n = rho >> 4, i = rho & 15; return 8 * (i >> 2) + 4 * n + (i & 3); }

struct Unit { int pm, pn; };
struct Gemm { const bf16_t* A; const bf16_t* Bt; int M, N, K, ld; };

struct StaticOrder {
    int nM, nN, nwg, G, c;
    __host__ __device__ void init(int M, int N, int G_, int c_) { nM = M / BM; nN = N / BM; nwg = nM * nN; G = G_; c = c_; }
    __host__ __device__ bool next(int i, Unit& u) const {
        const long L = (long)i * G + c; if (L >= nwg) return false;
        int wgid = (int)L; { const int q = nwg / NXCD, r = nwg % NXCD, xcd = wgid % NXCD, off = wgid / NXCD; wgid = (xcd < r ? xcd * (q + 1) : r * (q + 1) + (xcd - r) * q) + off; }
        const int nig = WGM * nN, gid = wgid / nig, fm = gid * WGM, gsz = (nM - fm) < WGM ? (nM - fm) : WGM;
        u.pm = fm + ((wgid % nig) % gsz); u.pn = (wgid % nig) / gsz; return true;
    }
    __device__ __forceinline__ void a_ready(const Unit&) const {}
    __device__ __forceinline__ void done(const Unit&) const {}
};

__device__ __forceinline__ unsigned cvt_pk_bf16(float lo, float hi) { unsigned r; asm volatile("v_cvt_pk_bf16_f32 %0, %1, %2" : "=v"(r) : "v"(lo), "v"(hi)); return r; }
template <class Epi, class Sched, bool ALIGN_EPI = false, bool SP2 = false>
__device__ __forceinline__ void gemm_phase(PG8_LAS unsigned char* lds, const Gemm g, const Sched& S, const Epi& E) {
    int tid_o = threadIdx.x; asm volatile("" : "+v"(tid_o));
    const int tid = tid_o, wid = __builtin_amdgcn_readfirstlane(tid >> 6), lane = tid & 63, wr = wid >> 2, wc = wid & 3, fr = lane & 15, fq = lane >> 4;
    const int K = g.ld  , nt = g.K / BK;
    unsigned voffA[2], voffB[2];
#pragma unroll
    for (int i = 0; i < 2; ++i) { int R, C; stage_rc(tid * 16 + i * 8192, R, C); const int Rb = Epi::PERM ? ((R & ~31) + perm32(R & 31)) : R;
        voffA[i] = (unsigned)(R * K + C) * 2u; voffB[i] = (unsigned)(Rb * K + C) * 2u; }
    const size_t kstep = (size_t)(BK * 2);
    const size_t hstep = (size_t)HALF * K * 2;
    const size_t tstep = 2 * hstep;
    const unsigned ldsw = (unsigned)wid * 1024u;
    const int aoff = lds_byte(wr * 64 + fr, fq * 8), boff = lds_byte(wc * 32 + fr, fq * 8);
#define PG8_SA(b, h) (((b) * 2 + (h)) * HTB)
#define PG8_SB(b, h) ((4 + (b) * 2 + (h)) * HTB)
#define PG8_STAGE(bufoff, gbase, voff) do { _Pragma("unroll") for (int _i = 0; _i < 2; ++_i) \
        __builtin_amdgcn_global_load_lds((const unsigned*)((const char*)(gbase) + (voff)[_i]), (PG8_LAS unsigned*)(lds + (bufoff) + ldsw + _i * 8192), 16, 0, 0); } while (0)
#define PG8_LDA(dst, b, h) do { _Pragma("unroll") for (int m = 0; m < 4; ++m) _Pragma("unroll") for (int k = 0; k < 2; ++k) dst[m][k] = *(const PG8_LAS bf16x8*)(lds + PG8_SA(b, h) + aoff + m * 2048 + k * 1024); } while (0)
#define PG8_LDB(dst, b, h) do { _Pragma("unroll") for (int n = 0; n < 2; ++n) _Pragma("unroll") for (int k = 0; k < 2; ++k) dst[n][k] = *(const PG8_LAS bf16x8*)(lds + PG8_SB(b, h) + boff + n * 2048 + k * 1024); } while (0)
#define PG8_MMA(ai, bj, At, Bt) do { __builtin_amdgcn_s_setprio(1); _Pragma("unroll") for (int m = 0; m < 4; ++m) _Pragma("unroll") for (int n = 0; n < 2; ++n) _Pragma("unroll") for (int k = 0; k < 2; ++k) \
        acc[ai][bj][m][n] = __builtin_amdgcn_mfma_f32_16x16x32_bf16(Bt[n][k], At[m][k], acc[ai][bj][m][n], 0, 0, 0); __builtin_amdgcn_s_setprio(0); } while (0)
#define PG8_WAIT_V(n) asm volatile("s_waitcnt vmcnt(" #n ")" ::: "memory")
#define PG8_WAIT_L(n) asm volatile("s_waitcnt lgkmcnt(" #n ")" ::: "memory")
#define PG8_BAR __builtin_amdgcn_s_barrier()
#define PG8_SCHED __builtin_amdgcn_sched_barrier(0)
    Unit cur, nxt; int ui = 0;
    if (!S.next(0, cur)) return;
    f32x4 acc[2][2][4][2];
#pragma unroll
    for (int a = 0; a < 2; ++a)
#pragma unroll
        for (int b = 0; b < 2; ++b)
#pragma unroll
            for (int m = 0; m < 4; ++m)
#pragma unroll
                for (int n = 0; n < 2; ++n) acc[a][b][m][n] = (f32x4){0.f, 0.f, 0.f, 0.f};
    bf16x8 At[4][2], B0[2][2], B1[2][2];
    const char* cA = (const char*)g.A + (size_t)cur.pm * tstep; const char* cB = (const char*)g.Bt + (size_t)cur.pn * tstep;
    S.a_ready(cur);
    if constexpr (SP2) {
        PG8_STAGE(PG8_SB(0, 0), cB, voffB); PG8_STAGE(PG8_SB(0, 1), cB + hstep, voffB); PG8_STAGE(PG8_SA(0, 0), cA, voffA); PG8_STAGE(PG8_SA(0, 1), cA + hstep, voffA);
        if (wr == 1) PG8_BAR;
        PG8_WAIT_V(2); PG8_BAR;
        PG8_STAGE(PG8_SB(1, 0), cB + kstep, voffB); PG8_STAGE(PG8_SA(1, 0), cA + kstep, voffA); PG8_STAGE(PG8_SB(1, 1), cB + hstep + kstep, voffB);
        PG8_WAIT_V(6); PG8_BAR;
    } else {
        PG8_STAGE(PG8_SB(0, 0), cB, voffB); PG8_STAGE(PG8_SA(0, 0), cA, voffA); PG8_STAGE(PG8_SB(0, 1), cB + hstep, voffB); PG8_STAGE(PG8_SA(0, 1), cA + hstep, voffA);
        if (wr == 1) PG8_BAR;
        PG8_WAIT_V(4); PG8_BAR;
        PG8_STAGE(PG8_SB(1, 0), cB + kstep, voffB); PG8_STAGE(PG8_SA(1, 0), cA + kstep, voffA); PG8_STAGE(PG8_SB(1, 1), cB + hstep + kstep, voffB);
        PG8_WAIT_V(6); PG8_BAR;
    }
    for (;;) {
        const bool has_next = S.next(ui + 1, nxt);
        const char* nA = has_next ? (const char*)g.A + (size_t)nxt.pm * tstep : cA; const char* nB = has_next ? (const char*)g.Bt + (size_t)nxt.pn * tstep : cB;
        for (int t = 0; t < nt; t += 2) {
            const bool last = (t == nt - 2);
            const char* a1 = cA + (size_t)(t + 1) * kstep;
            const char* a2 = last ? nA : cA + (size_t)(t + 2) * kstep; const char* b2 = last ? nB : cB + (size_t)(t + 2) * kstep;
            const char* a3 = a2 + kstep; const char* b3 = b2 + kstep;
            if (last && has_next) S.a_ready(nxt);
            if constexpr (SP2) {
            PG8_LDB(B0, 0, 0); PG8_LDB(B1, 0, 1); PG8_SCHED; PG8_LDA(At, 0, 0); PG8_STAGE(PG8_SA(1, 1), a1 + hstep, voffA);
            PG8_WAIT_V(8); PG8_WAIT_L(0); PG8_BAR; PG8_MMA(0, 0, At, B0); PG8_MMA(0, 1, At, B1); PG8_BAR; PG8_SCHED;
            PG8_LDA(At, 0, 1); PG8_STAGE(PG8_SB(0, 0), b2, voffB); PG8_STAGE(PG8_SB(0, 1), b2 + hstep, voffB); PG8_STAGE(PG8_SA(0, 0), a2, voffA);
            PG8_WAIT_V(8); PG8_WAIT_L(0); PG8_BAR; PG8_MMA(1, 0, At, B0); PG8_MMA(1, 1, At, B1); PG8_BAR; PG8_SCHED;
            PG8_LDB(B0, 1, 0); PG8_LDB(B1, 1, 1); PG8_SCHED; PG8_LDA(At, 1, 0); PG8_STAGE(PG8_SA(0, 1), a2 + hstep, voffA);
            PG8_WAIT_V(8); PG8_WAIT_L(0); PG8_BAR; PG8_MMA(0, 0, At, B0); PG8_MMA(0, 1, At, B1); PG8_BAR; PG8_SCHED;
            PG8_LDA(At, 1, 1); PG8_STAGE(PG8_SB(1, 0), b3, voffB); PG8_STAGE(PG8_SB(1, 1), b3 + hstep, voffB); PG8_STAGE(PG8_SA(1, 0), a3, voffA);
            PG8_WAIT_V(8); PG8_WAIT_L(0); PG8_BAR; PG8_MMA(1, 0, At, B0); PG8_MMA(1, 1, At, B1); PG8_BAR; PG8_SCHED;
            } else {
            PG8_LDB(B0, 0, 0); PG8_SCHED; PG8_LDA(At, 0, 0); PG8_STAGE(PG8_SA(1, 1), a1 + hstep, voffA);
            PG8_WAIT_L(8); PG8_BAR; PG8_WAIT_L(0); PG8_MMA(0, 0, At, B0); PG8_BAR; PG8_SCHED;
            PG8_LDB(B1, 0, 1); PG8_STAGE(PG8_SB(0, 0), b2, voffB);
            PG8_BAR; PG8_WAIT_L(0); PG8_MMA(0, 1, At, B1); PG8_BAR;
            PG8_LDA(At, 0, 1); PG8_STAGE(PG8_SA(0, 0), a2, voffA);
            PG8_BAR; PG8_WAIT_L(0); PG8_MMA(1, 0, At, B0); PG8_BAR; PG8_SCHED;
            PG8_STAGE(PG8_SB(0, 1), b2 + hstep, voffB);
            PG8_WAIT_V(6); PG8_BAR; PG8_MMA(1, 1, At, B1); PG8_BAR;
            PG8_LDB(B0, 1, 0); PG8_SCHED; PG8_LDA(At, 1, 0); PG8_STAGE(PG8_SA(0, 1), a2 + hstep, voffA);
            PG8_WAIT_L(8); PG8_BAR; PG8_WAIT_L(0); PG8_MMA(0, 0, At, B0); PG8_BAR; PG8_SCHED;
            PG8_LDB(B1, 1, 1); PG8_STAGE(PG8_SB(1, 0), b3, voffB);
            PG8_BAR; PG8_WAIT_L(0); PG8_MMA(0, 1, At, B1); PG8_BAR;
            PG8_LDA(At, 1, 1); PG8_STAGE(PG8_SA(1, 0), a3, voffA);
            PG8_BAR; PG8_WAIT_L(0); PG8_MMA(1, 0, At, B0); PG8_BAR; PG8_SCHED;
            PG8_STAGE(PG8_SB(1, 1), b3 + hstep, voffB);
            PG8_WAIT_V(6); PG8_BAR; PG8_MMA(1, 1, At, B1); PG8_BAR;
            }
        }
        if constexpr (ALIGN_EPI) { if (wr == 0) PG8_BAR; }
        if constexpr (!Epi::AFTER_DRAIN) { E(acc, cur, wr, wc, fr, fq); S.done(cur); }
        if (!has_next) break;
#pragma unroll
        for (int a = 0; a < 2; ++a)
#pragma unroll
            for (int b = 0; b < 2; ++b)
#pragma unroll
                for (int m = 0; m < 4; ++m)
#pragma unroll
                    for (int n = 0; n < 2; ++n) acc[a][b][m][n] = (f32x4){0.f, 0.f, 0.f, 0.f};
        cur = nxt; cA = nA; cB = nB; ++ui;
        if constexpr (ALIGN_EPI) { if (wr == 1) PG8_BAR; }
    }
    PG8_WAIT_V(0);
    if constexpr (!ALIGN_EPI) { if (wr == 0) PG8_BAR; }
    PG8_BAR;
    if constexpr (Epi::AFTER_DRAIN) { E.fused(acc, cur, wr, wc, fr, fq, lds, wid, lane); S.done(cur); }
#undef PG8_SA
#undef PG8_SB
#undef PG8_STAGE
#undef PG8_LDA
#undef PG8_LDB
#undef PG8_MMA
#undef PG8_WAIT_V
#undef PG8_WAIT_L
#undef PG8_BAR
#undef PG8_SCHED
}
}

namespace cg = cooperative_groups;
using pg8::bf16_t; using pg8::bf16x8; using pg8::f32x4; using pg8::u32x4;
typedef float f32x16 __attribute__((ext_vector_type(16)));
typedef unsigned u32x2 __attribute__((ext_vector_type(2)));
typedef float f32x2 __attribute__((ext_vector_type(2)));
#define LAS __attribute__((address_space(3)))

constexpr int DM = 1024, NPR = 65536, NSM = 2048, MTOK = NPR + NSM;
constexpr int NPROJ = 2816, INPROJ = 2824, DFF = 4096;
constexpr float EPS = 1e-5f;
constexpr float LOG2E = 1.4426950408889634f;
constexpr float QSCALE = -0.125f * LOG2E;
constexpr size_t O_Y = 0, O_KP = 69206016, O_VP = 102760448, O_CP = 136314880, O_SP = 136388608, O_KS = 137437184, O_VS = 138485760, O_CS = 139534336, O_SS = 139608064, O_END = 140656640;
constexpr size_t MiB = 1u << 20;
constexpr size_t WS_CTL = 0, WS_RSTD1 = 1 * MiB, WS_SSQ2 = 1 * MiB + 512 * 1024, WS_DTRAW = 3 * MiB, WS_WIN = 6 * MiB, WS_WOUT = 12 * MiB, WS_WUP = 14 * MiB, WS_WDN = 22 * MiB,
                 WS_KS = 30 * MiB, WS_VTS = 64 * MiB, WS_VTP = 98 * MiB, WS_MIX = 162 * MiB, WS_HB = 294 * MiB, WS_XB = 426 * MiB, WS_Q = 558 * MiB, WS_K = 624 * MiB, WS_Z = 690 * MiB,
                 WS_XBC = 756 * MiB, WS_U = 426 * MiB, WS_SBUF = 954 * MiB  , WS_LAM = 2 * MiB + 512 * 1024, WS_PART = 162 * MiB  , WS_END = 986 * MiB;
constexpr int RING_BYTES = 131072, VSTG_OFF = RING_BYTES, VSTG_WAVE = 2304, QSLOT_OFF = 159232, LDS_BYTES = 159744;
constexpr int NWAVES = 8, NTHR = 512;
constexpr int CW_BAR = 4096;
#define XCD_BAR_WORDS 3456

struct Args { const float* in[19]; float* out; unsigned char* ws; };

__device__ __forceinline__ unsigned cvt2(float lo, float hi) { return pg8::cvt_pk_bf16(lo, hi); }
__device__ __forceinline__ float bf_lo(unsigned w) { return __uint_as_float(w << 16); }
__device__ __forceinline__ float bf_hi(unsigned w) { return __uint_as_float(w & 0xffff0000u); }
__device__ __forceinline__ int crow(int r, int hi) { return (r & 3) + 8 * (r >> 2) + 4 * hi; }
__device__ __forceinline__ int pi32(int m) { return (m & 3) + 4 * (m >> 3) + 16 * ((m >> 2) & 1); }
__device__ __forceinline__ float wave_sum(float v) {
#pragma unroll
    for (int o = 1; o < 64; o <<= 1) v += __shfl_xor(v, o);
    return v;
}
__device__ __forceinline__ f32x16 mfma32(bf16x8 a, bf16x8 b, f32x16 c) { return __builtin_amdgcn_mfma_f32_32x32x16_bf16(a, b, c, 0, 0, 0); }

__device__ __forceinline__ u32x4 qt_swap(LAS u32x4* slot, u32x4 w, int fr, int fq, int lane) { slot[4 * fr + fq] = w; return slot[lane]; }
__device__ __forceinline__ u32x4 qt_unswap(LAS u32x4* slot, u32x4 w, int fr, int fq, int lane) { slot[lane] = w; return slot[4 * fr + fq]; }
struct EpiInProj {
    static constexpr bool PERM = true, AFTER_DRAIN = false;
    const float* rstd; float* out; unsigned char* ws; LAS unsigned char* lds;
    __device__ __forceinline__ void operator()(const f32x4 (&acc)[2][2][4][2], const pg8::Unit& u, int wr, int wc, int fr, int fq) const {
        const int pn = u.pn; const bool smp = u.pm >= 256;
        const int rbase = u.pm * 256 + wr * 64 + fr, cw = wc * 32 + 8 * fq;
        bf16_t* dst; int ldc, col0; float sc = 1.f; float* fo = nullptr;
        if (pn < 2) { dst = (bf16_t*)(ws + WS_Q); ldc = 512; col0 = pn * 256; sc = QSCALE; }
        else if (pn < 4) { dst = (bf16_t*)(ws + WS_K); ldc = 512; col0 = (pn - 2) * 256; fo = out + (smp ? O_KS : O_KP); }
        else if (pn < 6) { dst = nullptr; ldc = 512; col0 = (pn - 4) * 256; fo = out + (smp ? O_VS : O_VP); }
        else if (pn < 8) { dst = (bf16_t*)(ws + WS_Z); ldc = 512; col0 = (pn - 6) * 256; }
        else { dst = (bf16_t*)(ws + WS_XBC); ldc = 768; col0 = (pn - 8) * 256; }
        const bool isK = (pn == 2 || pn == 3), isV = (pn == 4 || pn == 5);
        const int lane = fr + 16 * fq, r4 = lane >> 2, c4 = lane & 3, r8 = lane >> 3, c8 = lane & 7;
        LAS u32x4* slot = (LAS u32x4*)(lds + VSTG_OFF + (wr * 4 + wc) * 3072);
        const int Rb = u.pm * 256 + wr * 64;
        float rs8[2][4];
#pragma unroll
        for (int ai = 0; ai < 2; ++ai)
#pragma unroll
            for (int m = 0; m < 4; ++m) rs8[ai][m] = rstd[rbase + ai * 128 + m * 16];
#pragma unroll
        for (int ai = 0; ai < 2; ++ai)
#pragma unroll
            for (int m = 0; m < 4; ++m) { const int Rg = Rb + ai * 128 + m * 16; const float s = rs8[ai][m] * sc;
                const int rowp = Rg + r4;
                size_t brow = (size_t)rowp;
                if (isK && smp) { const int rr = rowp - NPR; brow = (size_t)(rr >> 6) * 1088 + 1024 + (rr & 63); dst = (bf16_t*)(ws + WS_KS); }
                const size_t frA = (size_t)(smp ? Rg - NPR : Rg) + r8;
#pragma unroll
                for (int bj = 0; bj < 2; ++bj) { const int c = col0 + bj * 128 + wc * 32; const f32x4 v0 = acc[ai][bj][m][0] * s, v1 = acc[ai][bj][m][1] * s;
                    if (fo) { slot[8 * fr + 2 * fq] = __builtin_bit_cast(u32x4, v0); slot[8 * fr + 2 * fq + 1] = __builtin_bit_cast(u32x4, v1);
                        const u32x4 pa_ = slot[lane], pb_ = slot[64 + lane];
                        *(u32x4*)(fo + frA * 512 + c + 4 * c8) = pa_; *(u32x4*)(fo + (frA + 8) * 512 + c + 4 * c8) = pb_; }
                    if (!isV) { f32x4 y0 = v0, y1 = v1;
                        if (pn == 6 || pn == 7) {
#pragma unroll
                            for (int e = 0; e < 4; ++e) { y0[e] = y0[e] * __builtin_amdgcn_rcpf(1.f + __builtin_amdgcn_exp2f(-y0[e] * LOG2E)); y1[e] = y1[e] * __builtin_amdgcn_rcpf(1.f + __builtin_amdgcn_exp2f(-y1[e] * LOG2E)); } }
                        u32x4 w; w.x = cvt2(y0[0], y0[1]); w.y = cvt2(y0[2], y0[3]); w.z = cvt2(y1[0], y1[1]); w.w = cvt2(y1[2], y1[3]);
                        *(u32x4*)(dst + brow * ldc + c + 8 * c4) = qt_swap(slot + 128, w, fr, fq, lane); } }
                asm volatile("" ::: "memory"); }
        if (isV) {
            const int wid = wr * 4 + wc;
            LAS unsigned short* stg = (LAS unsigned short*)(lds + VSTG_OFF + wid * 3072);
#pragma unroll
            for (int ai = 0; ai < 2; ++ai) {
                float rs[4];
#pragma unroll
                for (int m = 0; m < 4; ++m) rs[m] = rs8[ai][m];
                const int R0 = u.pm * 256 + ai * 128 + wr * 64;
                bf16_t* vbase = !smp ? (bf16_t*)(ws + WS_VTP) + ((size_t)((R0 >> 11) * 512)) * 2048 + (R0 & 2047)
                                     : (bf16_t*)(ws + WS_VTS) + ((size_t)(((R0 - NPR) >> 6) * 512)) * 1088 + 1024;
                const int vpitch = smp ? 1088 : 2048;
#pragma unroll
                for (int bj = 0; bj < 2; ++bj)
#pragma unroll
                    for (int n = 0; n < 2; ++n) {
#pragma unroll
                        for (int m = 0; m < 4; ++m) { const f32x4 v = acc[ai][bj][m][n] * rs[m];
                            const unsigned w01 = cvt2(v[0], v[1]), w23 = cvt2(v[2], v[3]);
                            stg[(4 * fq + 0) * 72 + 16 * m + fr] = (unsigned short)(w01 & 0xffffu); stg[(4 * fq + 1) * 72 + 16 * m + fr] = (unsigned short)(w01 >> 16);
                            stg[(4 * fq + 2) * 72 + 16 * m + fr] = (unsigned short)(w23 & 0xffffu); stg[(4 * fq + 3) * 72 + 16 * m + fr] = (unsigned short)(w23 >> 16); }
                        asm volatile("s_waitcnt lgkmcnt(0)" ::: "memory");
#pragma unroll
                        for (int i = 0; i < 2; ++i) { const int piece = i * 64 + lane, ci = piece >> 3, ch = piece & 7;
                            const u32x4 v = *(const LAS u32x4*)(stg + ci * 72 + 8 * ch);
                            const int vcol = col0 + bj * 128 + wc * 32 + 8 * (ci >> 2) + 4 * n + (ci & 3);
                            *(u32x4*)(vbase + (size_t)vcol * vpitch + 8 * ch) = v; }
                        asm volatile("s_waitcnt lgkmcnt(0)" ::: "memory");
                    }
            }
        }
    }
};

struct EpiOutProj {
    static constexpr bool PERM = true, AFTER_DRAIN = false;
    const bf16_t* XB; bf16_t* HB; float* ssq; LAS unsigned char* lds;
    __device__ __forceinline__ void operator()(const f32x4 (&acc)[2][2][4][2], const pg8::Unit& u, int wr, int wc, int fr, int fq) const {
        const int rbase = u.pm * 256 + wr * 64 + fr, lane = fr + 16 * fq;
        LAS u32x4* slot = (LAS u32x4*)(lds + VSTG_OFF + (wr * 4 + wc) * 3072);
        const size_t poff = (size_t)(u.pm * 256 + wr * 64 + (lane >> 2)) * DM + u.pn * 256 + wc * 32 + 8 * (lane & 3);
        const bf16_t* xb = XB + poff; bf16_t* hb = HB + poff;
        u32x4 pre[8][2];
#pragma unroll
        for (int g = 0; g < 8; ++g) { const bf16_t* p_ = xb + (size_t)((g >> 2) * 128 + (g & 3) * 16) * DM; pre[g][0] = *(const u32x4*)p_; pre[g][1] = *(const u32x4*)(p_ + 128); }
#pragma unroll
        for (int g = 0; g < 8; ++g) { const int ai = g >> 2, m = g & 3; const int row = rbase + ai * 128 + m * 16;
            bf16_t* hr = hb + (size_t)(ai * 128 + m * 16) * DM; float s = 0.f;
#pragma unroll
            for (int bj = 0; bj < 2; ++bj) { const u32x4 r = qt_unswap(slot + ((2 * g + bj) % 3) * 64, pre[g][bj], fr, fq, lane);
                const f32x4 h0 = (f32x4){bf_lo(r.x), bf_hi(r.x), bf_lo(r.y), bf_hi(r.y)} + acc[ai][bj][m][0], h1 = (f32x4){bf_lo(r.z), bf_hi(r.z), bf_lo(r.w), bf_hi(r.w)} + acc[ai][bj][m][1];
                u32x4 w; w.x = cvt2(h0[0], h0[1]); w.y = cvt2(h0[2], h0[3]); w.z = cvt2(h1[0], h1[1]); w.w = cvt2(h1[2], h1[3]);
                *(u32x4*)(hr + bj * 128) = qt_swap(slot + ((2 * g + bj + 1) % 3) * 64, w, fr, fq, lane);
                s += (h0[0] * h0[0] + h0[1] * h0[1]) + (h0[2] * h0[2] + h0[3] * h0[3]) + (h1[0] * h1[0] + h1[1] * h1[1]) + (h1[2] * h1[2] + h1[3] * h1[3]); }
            s += __shfl_xor(s, 16); s += __shfl_xor(s, 32);
            if (fq == 0) __hip_atomic_fetch_add(ssq + row, s, __ATOMIC_RELAXED, __HIP_MEMORY_SCOPE_AGENT); }
    }
};

struct EpiUp {
    static constexpr bool PERM = true, AFTER_DRAIN = false;
    const float* ssq; bf16_t* U; LAS unsigned char* lds;
    __device__ __forceinline__ void operator()(const f32x4 (&acc)[2][2][4][2], const pg8::Unit& u, int wr, int wc, int fr, int fq) const {
        const int rbase = u.pm * 256 + wr * 64 + fr, lane = fr + 16 * fq;
        LAS u32x4* slot = (LAS u32x4*)(lds + VSTG_OFF + (wr * 4 + wc) * 3072);
        bf16_t* ub = U + (size_t)(u.pm * 256 + wr * 64 + (lane >> 2)) * DFF + u.pn * 256 + wc * 32 + 8 * (lane & 3);
        float q8[2][4];
#pragma unroll
        for (int ai = 0; ai < 2; ++ai)
#pragma unroll
            for (int m = 0; m < 4; ++m) q8[ai][m] = ssq[rbase + ai * 128 + m * 16];
#pragma unroll
        for (int ai = 0; ai < 2; ++ai)
#pragma unroll
            for (int m = 0; m < 4; ++m) { const float s = rsqrtf(q8[ai][m] * (1.0f / DM) + EPS); bf16_t* rp = ub + (size_t)(ai * 128 + m * 16) * DFF;
#pragma unroll
                for (int bj = 0; bj < 2; ++bj) { f32x4 v0 = acc[ai][bj][m][0] * s, v1 = acc[ai][bj][m][1] * s;
#pragma unroll
                    for (int e = 0; e < 4; ++e) { v0[e] = fmaxf(v0[e], 0.f); v1[e] = fmaxf(v1[e], 0.f); }
                    v0 = v0 * v0; v1 = v1 * v1;
                    u32x4 w; w.x = cvt2(v0[0], v0[1]); w.y = cvt2(v0[2], v0[3]); w.z = cvt2(v1[0], v1[1]); w.w = cvt2(v1[2], v1[3]);
                    *(u32x4*)(rp + bj * 128) = qt_swap(slot + (2 * m + bj) % 3 * 64, w, fr, fq, lane); } }
    }
};

struct EpiDown {
    static constexpr bool PERM = true, AFTER_DRAIN = false;
    bf16_t* HB; LAS unsigned char* lds;
    __device__ __forceinline__ void operator()(const f32x4 (&acc)[2][2][4][2], const pg8::Unit& u, int wr, int wc, int fr, int fq) const {
        const int lane = fr + 16 * fq;
        LAS u32x4* slot = (LAS u32x4*)(lds + VSTG_OFF + (wr * 4 + wc) * 3072);
        bf16_t* hb = HB + (size_t)(u.pm * 256 + wr * 64 + (lane >> 2)) * DM + u.pn * 256 + wc * 32 + 8 * (lane & 3);
        u32x4 pre[8][2];
#pragma unroll
        for (int g = 0; g < 8; ++g) { const bf16_t* p_ = hb + (size_t)((g >> 2) * 128 + (g & 3) * 16) * DM; pre[g][0] = *(const u32x4*)p_; pre[g][1] = *(const u32x4*)(p_ + 128); }
#pragma unroll
        for (int g = 0; g < 8; ++g) { const int ai = g >> 2, m = g & 3; bf16_t* hr = hb + (size_t)(ai * 128 + m * 16) * DM;
#pragma unroll
            for (int bj = 0; bj < 2; ++bj) { const u32x4 r = qt_unswap(slot + ((2 * g + bj) % 3) * 64, pre[g][bj], fr, fq, lane); const f32x4 a0 = acc[ai][bj][m][0], a1 = acc[ai][bj][m][1];
                u32x4 w; w.x = cvt2(bf_lo(r.x) + a0[0], bf_hi(r.x) + a0[1]); w.y = cvt2(bf_lo(r.y) + a0[2], bf_hi(r.y) + a0[3]); w.z = cvt2(bf_lo(r.z) + a1[0], bf_hi(r.z) + a1[1]); w.w = cvt2(bf_lo(r.w) + a1[2], bf_hi(r.w) + a1[3]);
                *(u32x4*)(hr + bj * 128) = qt_swap(slot + ((2 * g + bj + 1) % 3) * 64, w, fr, fq, lane); } }
    }
};
struct EpiDownPart {
    static constexpr bool PERM = true, AFTER_DRAIN = false;
    float* P;
    __device__ __forceinline__ void operator()(const f32x4 (&acc)[2][2][4][2], const pg8::Unit& u, int wr, int wc, int fr, int fq) const {
        const int rbase = (u.pm - 256) * 256 + wr * 64 + fr, cw = u.pn * 256 + wc * 32 + 8 * fq;
#pragma unroll
        for (int ai = 0; ai < 2; ++ai)
#pragma unroll
            for (int m = 0; m < 4; ++m) { float* pr = P + (size_t)(rbase + ai * 128 + m * 16) * DM + cw;
#pragma unroll
                for (int bj = 0; bj < 2; ++bj) { *(f32x4*)(pr + bj * 128) = acc[ai][bj][m][0]; *(f32x4*)(pr + bj * 128 + 4) = acc[ai][bj][m][1]; } }
    }
};
struct TailOrder {
    int pm, pn;
    __device__ bool next(int i, pg8::Unit& u) const { if (i > 0) return false; u.pm = pm; u.pn = pn; return true; }
    __device__ __forceinline__ void a_ready(const pg8::Unit&) const {}
    __device__ __forceinline__ void done(const pg8::Unit&) const {}
};
struct TailAll {
    int G, c;
    __device__ void init(int G_, int c_) { G = G_; c = c_; }
    __device__ bool next(int i, pg8::Unit& u) const { const int L = i * G + c; if (L >= 32) return false; u.pm = 256 + (L >> 2); u.pn = L & 3; return true; }
    __device__ __forceinline__ void a_ready(const pg8::Unit&) const {}
    __device__ __forceinline__ void done(const pg8::Unit&) const {}
};

struct TItem { const float* W; const float* ksc; bf16_t* WT; int ldw, ldt, k0, n0; };
__device__ __forceinline__ void titem_load(const TItem& t, f32x4 (&v)[8], int lane) {
#pragma unroll
    for (int i = 0; i < 8; ++i) { const int kk = 8 * i + (lane >> 3); v[i] = *(const f32x4*)(t.W + (size_t)(t.k0 + kk) * t.ldw + t.n0 + 4 * (lane & 7)); }
}
__device__ __forceinline__ void titem_finish(const TItem& t, const f32x4 (&v)[8], LAS float* scr, int lane) {
#pragma unroll
    for (int i = 0; i < 8; ++i) { const int kk = 8 * i + (lane >> 3); f32x4 x = v[i]; if (t.ksc) x = x * t.ksc[t.k0 + kk]; LAS float* d = scr + kk * 33 + 4 * (lane & 7); d[0] = x[0]; d[1] = x[1]; d[2] = x[2]; d[3] = x[3]; }
    asm volatile("s_waitcnt lgkmcnt(0)" ::: "memory");
    const int c = lane & 7;
#pragma unroll
    for (int j = 0; j < 4; ++j) { const int n = (lane >> 3) + 8 * j; const LAS float* s = scr + (8 * c) * 33 + n;
        u32x4 o; o.x = cvt2(s[0 * 33], s[1 * 33]); o.y = cvt2(s[2 * 33], s[3 * 33]); o.z = cvt2(s[4 * 33], s[5 * 33]); o.w = cvt2(s[6 * 33], s[7 * 33]);
        *(u32x4*)(t.WT + (size_t)(t.n0 + n) * t.ldt + t.k0 + 8 * c) = o; }
    asm volatile("s_waitcnt lgkmcnt(0)" ::: "memory");
}
constexpr int I_IN = 16 * 88, I_OUT = 16 * 32, I_UP = 16 * 128, I_DN = 64 * 32, NIT = I_IN + I_OUT + I_UP + I_DN;
__device__ __forceinline__ TItem titem_decode(const Args& a, int it) {
    unsigned char* ws = a.ws; int r = it; TItem t;
    if (r < I_IN) { t = TItem{a.in[7], a.in[6], (bf16_t*)(ws + WS_WIN), INPROJ, 1024, 64 * (r / 88), 32 * (r % 88)}; return t; } r -= I_IN;
    if (r < I_OUT) { t = TItem{a.in[14], nullptr, (bf16_t*)(ws + WS_WOUT), 1024, 1024, 64 * (r / 32), 32 * (r % 32)}; return t; } r -= I_OUT;
    if (r < I_UP) { t = TItem{a.in[16], a.in[15], (bf16_t*)(ws + WS_WUP), 4096, 1024, 64 * (r / 128), 32 * (r % 128)}; return t; } r -= I_UP;
    t = TItem{a.in[17], nullptr, (bf16_t*)(ws + WS_WDN), 1024, 4096, 64 * (r / 32), 32 * (r % 32)};
    return t;
}

__device__ __forceinline__ void p0_prologue(const Args& a, LAS unsigned char* lds, int tid, int wid, int lane) {
    unsigned char* ws = a.ws;
    const int G = gridDim.x, gw = blockIdx.x * NWAVES + wid, NGW = G * NWAVES;
    const int gt = blockIdx.x * NTHR + tid, NGT = G * NTHR;
    { float* ssq = (float*)(ws + WS_SSQ2); for (int i = gt; i < MTOK; i += NGT) ssq[i] = 0.f; unsigned* ctl = (unsigned*)(ws + WS_CTL); if (gt < 64) ctl[gt] = 0u; }
    { LAS float* scr = (LAS float*)(lds + wid * 8448);
      if (gw < NIT) { TItem cur = titem_decode(a, gw); f32x4 v[8]; titem_load(cur, v, lane);
        for (int it = gw; it < NIT; it += NGW) { const int nit = it + NGW; TItem nx = cur; f32x4 vn[8];
#pragma unroll
            for (int i = 0; i < 8; ++i) vn[i] = v[i];
            { nx = titem_decode(a, nit < NIT ? nit : it); titem_load(nx, vn, lane); }
            titem_finish(cur, v, scr, lane);
            cur = nx;
#pragma unroll
            for (int i = 0; i < 8; ++i) v[i] = vn[i]; } } }
    { const float* nw = a.in[6]; const float* win = a.in[7];
      float wd[4][4][8];
#pragma unroll
      for (int j = 0; j < 4; ++j)
#pragma unroll
          for (int e = 0; e < 4; ++e) { const int k = 256 * j + 4 * lane + e; const float s = nw[k]; const f32x4 w0 = *(const f32x4*)(win + (size_t)k * INPROJ + NPROJ), w1 = *(const f32x4*)(win + (size_t)k * INPROJ + NPROJ + 4);
#pragma unroll
              for (int q = 0; q < 4; ++q) { wd[j][e][q] = w0[q] * s; wd[j][e][4 + q] = w1[q] * s; } }
      bf16_t* XB = (bf16_t*)(ws + WS_XB); float* rstd = (float*)(ws + WS_RSTD1); float* dtr = (float*)(ws + WS_DTRAW);
      f32x4 v[4], vn1[4];
#define XROW_PTR(r_) ((r_) < NPR ? a.in[0] + (size_t)(r_) * DM : a.in[1] + (size_t)((r_) - NPR) * DM)
      { const float* xr = XROW_PTR(gw);
#pragma unroll
        for (int j = 0; j < 4; ++j) v[j] = *(const f32x4*)(xr + 256 * j + 4 * lane);
        const int r1 = gw + NGW < MTOK ? gw + NGW : gw; const float* xr1 = XROW_PTR(r1);
#pragma unroll
        for (int j = 0; j < 4; ++j) vn1[j] = *(const f32x4*)(xr1 + 256 * j + 4 * lane); }
      const bool b0 = lane & 1, b1 = lane & 2, b2 = lane & 4; const int didx = ((lane & 1) << 2) | (lane & 2) | ((lane >> 2) & 1);
      for (int row = gw; row < MTOK; row += NGW) {
          const int nrow = row + 2 * NGW; f32x4 vn[4];
          { const int nr_ = nrow < MTOK ? nrow : row; const float* xr = XROW_PTR(nr_);
#pragma unroll
              for (int j = 0; j < 4; ++j) vn[j] = *(const f32x4*)(xr + 256 * j + 4 * lane); }
          float ss = 0.f; float d[8];
#pragma unroll
          for (int q = 0; q < 8; ++q) d[q] = 0.f;
#pragma unroll
          for (int j = 0; j < 4; ++j) { ss += (v[j][0] * v[j][0] + v[j][1] * v[j][1]) + (v[j][2] * v[j][2] + v[j][3] * v[j][3]);
#pragma unroll
              for (int e = 0; e < 4; ++e)
#pragma unroll
                  for (int q = 0; q < 8; ++q) d[q] += v[j][e] * wd[j][e][q]; }
          ss = wave_sum(ss);
          float c4[4], c2[2], c1;
#pragma unroll
          for (int i = 0; i < 4; ++i) { const float keep = b0 ? d[4 + i] : d[i], send = b0 ? d[i] : d[4 + i]; c4[i] = keep + __shfl_xor(send, 1); }
#pragma unroll
          for (int i = 0; i < 2; ++i) { const float keep = b1 ? c4[2 + i] : c4[i], send = b1 ? c4[i] : c4[2 + i]; c2[i] = keep + __shfl_xor(send, 2); }
          { const float keep = b2 ? c2[1] : c2[0], send = b2 ? c2[0] : c2[1]; c1 = keep + __shfl_xor(send, 4); }
          c1 += __shfl_xor(c1, 8); c1 += __shfl_xor(c1, 16); c1 += __shfl_xor(c1, 32);
          const float rs = rsqrtf(ss * (1.0f / DM) + EPS);
#pragma unroll
          for (int j = 0; j < 4; ++j) { u32x2 w; w.x = cvt2(v[j][0], v[j][1]); w.y = cvt2(v[j][2], v[j][3]); *(u32x2*)(XB + (size_t)row * DM + 256 * j + 4 * lane) = w; }
          if (lane < 8) dtr[(size_t)row * 8 + didx] = c1 * rs;
          if (lane == 0) rstd[row] = rs;
#pragma unroll
          for (int j = 0; j < 4; ++j) { v[j] = vn1[j]; vn1[j] = vn[j]; }
      } }
#undef XROW_PTR
}

__device__ __forceinline__ float sb_half(f32x16& p) {
    float run = 1.f;
#pragma unroll
    for (int r = 15; r >= 0; --r) {
        const float e = __builtin_amdgcn_exp2f(p[r]);
        const float beta = __builtin_amdgcn_rcpf(1.f + e);
        p[r] = beta * run;
        run *= (1.f - beta);
    }
    return run;
}
template <bool SMP> __device__ __forceinline__ void attn_unit(const bf16_t* Qp, const bf16_t* Kp, const bf16_t* Vtp, int vp, int qpos0, bf16_t* Op, const float* ck, const float* cv, LAS bf16_t* stg, int lane) {
    const int lr = lane & 31, hi = lane >> 5;
    bf16x8 qf[4];
#pragma unroll
    for (int d0 = 0; d0 < 4; ++d0) qf[d0] = *(const bf16x8*)(Qp + (size_t)lr * 512 + 16 * d0 + 8 * hi);
    const bf16_t* kl = Kp + (size_t)pi32(lr) * 512 + 8 * hi;
    const bf16_t* vl = Vtp + (size_t)lr * vp + 16 * hi;
    f32x16 o0, o1;
#pragma unroll
    for (int r = 0; r < 16; ++r) { o0[r] = 0.f; o1[r] = 0.f; }
    float C = 1.f; const int qpos = qpos0 + lr;
    int t = qpos0 >> 6;
    bf16x8 kf[2][4];
    const float* ckl = SMP ? ck + (size_t)pi32(lr) * 512 + 8 * hi : nullptr;
#define ATT_LOADK(tt) do { \
        if (SMP && (tt) < 16) { _Pragma("unroll") for (int sub = 0; sub < 2; ++sub) _Pragma("unroll") for (int d0 = 0; d0 < 4; ++d0) { const float* p_ = ckl + (size_t)(64 * (tt) + 32 * sub) * 512 + 16 * d0; \
                const f32x4 x0_ = *(const f32x4*)p_, x1_ = *(const f32x4*)(p_ + 4); u32x4 w_; w_.x = cvt2(x0_[0], x0_[1]); w_.y = cvt2(x0_[2], x0_[3]); w_.z = cvt2(x1_[0], x1_[1]); w_.w = cvt2(x1_[2], x1_[3]); kf[sub][d0] = __builtin_bit_cast(bf16x8, w_); } } \
        else { _Pragma("unroll") for (int sub = 0; sub < 2; ++sub) _Pragma("unroll") for (int d0 = 0; d0 < 4; ++d0) kf[sub][d0] = *(const bf16x8*)(kl + (size_t)(64 * (tt) + 32 * sub) * 512 + 16 * d0); } } while (0)
#define ATT_LOADV(dst, tt) do { _Pragma("unroll") for (int db = 0; db < 2; ++db) _Pragma("unroll") for (int ks = 0; ks < 4; ++ks) dst[db][ks] = *(const bf16x8*)(vl + (size_t)(32 * db) * vp + 64 * (tt) + (ks >> 1) * 32 + 8 * (ks & 1)); } while (0)
    bf16x8 vf[2][4];
    u32x4 sk[8], sv[8];
    const int srow = lane >> 3, sch = lane & 7;
    const bf16_t* kco = Kp + (size_t)srow * 512 + 8 * sch; const bf16_t* vco = Vtp + (size_t)srow * vp + 8 * sch;
    LAS bf16_t* KT = stg; LAS bf16_t* VT = stg + 64 * 72;
#define ATT_LOADCO(tt) do { _Pragma("unroll") for (int i = 0; i < 8; ++i) { sk[i] = *(const u32x4*)(kco + (size_t)(64 * (tt) + 8 * i) * 512); sv[i] = *(const u32x4*)(vco + (size_t)(8 * i) * vp + 64 * (tt)); } } while (0)
    if (SMP) ATT_LOADK(t); else ATT_LOADCO(t);
    for (;;) {
        if (!SMP) {
#pragma unroll
            for (int i = 0; i < 8; ++i) { *(LAS u32x4*)(KT + (8 * i + srow) * 72 + 8 * sch) = sk[i]; *(LAS u32x4*)(VT + (8 * i + srow) * 72 + 8 * sch) = sv[i]; }
            const int tp_ = t > 0 ? t - 1 : 0; ATT_LOADCO(tp_);
#pragma unroll
            for (int sub = 0; sub < 2; ++sub)
#pragma unroll
                for (int d0 = 0; d0 < 4; ++d0) kf[sub][d0] = *(const LAS bf16x8*)(KT + (32 * sub + pi32(lr)) * 72 + 16 * d0 + 8 * hi);
        }
        f32x16 p0, p1;
#pragma unroll
        for (int r = 0; r < 16; ++r) { p0[r] = 0.f; p1[r] = 0.f; }
#pragma unroll
        for (int d0 = 0; d0 < 4; ++d0) { p0 = mfma32(kf[0][d0], qf[d0], p0); p1 = mfma32(kf[1][d0], qf[d0], p1); }
        const int tb = t * 64;
        const int tn_ = t > 0 ? t - 1 : 0; if (SMP) ATT_LOADK(tn_);
        if (!SMP) {
#pragma unroll
            for (int db = 0; db < 2; ++db)
#pragma unroll
                for (int ks = 0; ks < 4; ++ks) vf[db][ks] = *(const LAS bf16x8*)(VT + (32 * db + lr) * 72 + (ks >> 1) * 32 + 16 * hi + 8 * (ks & 1));
        } else if (t < 16) {
#pragma unroll
            for (int db = 0; db < 2; ++db)
#pragma unroll
                for (int ks = 0; ks < 4; ++ks) { const float* p_ = cv + (size_t)(tb + (ks >> 1) * 32 + 16 * hi + 8 * (ks & 1)) * 512 + 32 * db + lr; float x_[8];
#pragma unroll
                    for (int i = 0; i < 8; ++i) x_[i] = p_[(size_t)i * 512];
                    u32x4 w_; w_.x = cvt2(x_[0], x_[1]); w_.y = cvt2(x_[2], x_[3]); w_.z = cvt2(x_[4], x_[5]); w_.w = cvt2(x_[6], x_[7]); vf[db][ks] = __builtin_bit_cast(bf16x8, w_); }
        } else ATT_LOADV(vf, t);
        float T1 = 1.f;
        if (tb + 63 >= qpos0) {
#pragma unroll
            for (int r = 0; r < 16; ++r) { if (tb + 16 * hi + r >= qpos) p0[r] = 3.0e38f; if (tb + 32 + 16 * hi + r >= qpos) p1[r] = 3.0e38f; }
        }
        if (tb + 32 > qpos0 + 30) {
#pragma unroll
            for (int r = 0; r < 16; ++r) p1[r] = 0.f;
        } else T1 = sb_half(p1);
        const float T0 = sb_half(p0);
        const float T1o = __shfl_xor(T1, 32), T0o = __shfl_xor(T0, 32);
        const float T1hi = hi ? T1 : T1o, T1lo = hi ? T1o : T1, T0hi = hi ? T0 : T0o, T0lo = hi ? T0o : T0;
        const float M1 = hi ? C : C * T1hi;
        const float c2 = C * T1hi * T1lo;
        const float M0 = hi ? c2 : c2 * T0hi;
        C = c2 * T0hi * T0lo;
        if (C < 1.17549435e-38f) C = 0.f;
        bf16x8 pa[4];
        { u32x4 w;
          w.x = cvt2(p0[0] * M0, p0[1] * M0); w.y = cvt2(p0[2] * M0, p0[3] * M0); w.z = cvt2(p0[4] * M0, p0[5] * M0); w.w = cvt2(p0[6] * M0, p0[7] * M0); pa[0] = __builtin_bit_cast(bf16x8, w);
          w.x = cvt2(p0[8] * M0, p0[9] * M0); w.y = cvt2(p0[10] * M0, p0[11] * M0); w.z = cvt2(p0[12] * M0, p0[13] * M0); w.w = cvt2(p0[14] * M0, p0[15] * M0); pa[1] = __builtin_bit_cast(bf16x8, w);
          w.x = cvt2(p1[0] * M1, p1[1] * M1); w.y = cvt2(p1[2] * M1, p1[3] * M1); w.z = cvt2(p1[4] * M1, p1[5] * M1); w.w = cvt2(p1[6] * M1, p1[7] * M1); pa[2] = __builtin_bit_cast(bf16x8, w);
          w.x = cvt2(p1[8] * M1, p1[9] * M1); w.y = cvt2(p1[10] * M1, p1[11] * M1); w.z = cvt2(p1[12] * M1, p1[13] * M1); w.w = cvt2(p1[14] * M1, p1[15] * M1); pa[3] = __builtin_bit_cast(bf16x8, w); }
#pragma unroll
        for (int ks = 0; ks < 4; ++ks) { o0 = mfma32(vf[0][ks], pa[ks], o0); o1 = mfma32(vf[1][ks], pa[ks], o1); }
        if (t == 0 || __all(C == 0.f)) break;
        --t;
    }
#pragma unroll
    for (int g4 = 0; g4 < 4; ++g4) {
        u32x2 w; w.x = cvt2(o0[4 * g4], o0[4 * g4 + 1]); w.y = cvt2(o0[4 * g4 + 2], o0[4 * g4 + 3]); *(u32x2*)(Op + (size_t)lr * DM + 8 * g4 + 4 * hi) = w;
        w.x = cvt2(o1[4 * g4], o1[4 * g4 + 1]); w.y = cvt2(o1[4 * g4 + 2], o1[4 * g4 + 3]); *(u32x2*)(Op + (size_t)lr * DM + 32 + 8 * g4 + 4 * hi) = w;
    }
}
#undef ATT_LOADK
#undef ATT_LOADV
#undef ATT_LOADCO

constexpr int TP = 72, TSZ = 64 * TP * 2;
constexpr int L_CM = 0, L_BM = TSZ, L_BT = 2 * TSZ, L_XDT = 3 * TSZ, L_XDTE = 7 * TSZ, L_HT = 11 * TSZ, L_AUX = 15 * TSZ  , AUXB = 5120, L_SSQ = L_AUX + 2 * AUXB  ,
              L_CW = L_SSQ + 2048  , L_NW = L_CW + 7680  ;
static_assert(L_NW + 1024 == QSLOT_OFF, "LDS map");
__device__ __forceinline__ bf16x8 ld16(const LAS bf16_t* p) { return *(const LAS bf16x8*)p; }
__device__ __forceinline__ float silu_f(float x) { return x * __builtin_amdgcn_rcpf(1.f + __builtin_amdgcn_exp2f(-x * LOG2E)); }
__device__ __forceinline__ int ssd_gch(int lc, int g) { return lc < 256 ? g * 256 + lc : (lc < 320 ? 512 + g * 64 + (lc - 256) : 640 + g * 64 + (lc - 320)); }

__device__ __forceinline__ void ssd_item(const Args& a, LAS unsigned char* lds, int b, int g, bool smp, int sc, int mode, int tid, int wid, int lane) {
    unsigned char* ws = a.ws;
    const bf16_t* XBC = (const bf16_t*)(ws + WS_XBC); const bf16_t* Z = (const bf16_t*)(ws + WS_Z); const float* DTR = (const float*)(ws + WS_DTRAW); bf16_t* MIX = (bf16_t*)(ws + WS_MIX);
    LAS bf16_t* CM = (LAS bf16_t*)(lds + L_CM); LAS bf16_t* BM = (LAS bf16_t*)(lds + L_BM); LAS bf16_t* BT = (LAS bf16_t*)(lds + L_BT);
    LAS float* SSQ = (LAS float*)(lds + L_SSQ); LAS float* CW = (LAS float*)(lds + L_CW); LAS float* NW = (LAS float*)(lds + L_NW);
    const int nch = smp ? 1 : 4; const int tok0 = smp ? NPR + b * 64 : b * 2048 + 256 * sc; const bool full = (mode != 0), last = smp || sc == 7;
    float* SBUF = (float*)(ws + WS_SBUF); float* LAM = (float*)(ws + WS_LAM); float lam = 0.f;
    const int hh = wid >> 1, ph = wid & 1; const int head = g * 4 + hh;
#define SSD_LANE() int ln_ = lane; asm volatile("" : "+v"(ln_)); const int lr = ln_ & 31, hi = ln_ >> 5
#define AUX(buf, k) ((LAS float*)(lds + L_AUX + (buf) * AUXB + (k) * 1024))
    LAS bf16_t* XDT = (LAS bf16_t*)(lds + L_XDT + hh * TSZ); LAS bf16_t* XDTE = (LAS bf16_t*)(lds + L_XDTE + hh * TSZ); LAS bf16_t* HT = (LAS bf16_t*)(lds + L_HT + hh * TSZ);
    const int h4 = (tid >> 6) & 3, tt_ = tid & 63;
    unsigned raw[3][11]; float dtr_v = 0.f; u32x2 zc[2][4];
#pragma unroll
    for (int i = 0; i < 3; ++i) { const int it = tid + NTHR * i, cp = it % 192, ts = it / 192, gch = ssd_gch(2 * cp, g); const unsigned o0 = (unsigned)((tok0 + 8 * ts - 3) * 768 + gch);
#pragma unroll
        for (int j = 3; j < 11; ++j) raw[i][j] = *(const unsigned*)(XBC + (o0 + (unsigned)(j * 768)));
#pragma unroll
        for (int j = 0; j < 3; ++j) { unsigned v = 0u;
            if (ts > 0 || sc > 0) v = *(const unsigned*)(XBC + (o0 + (unsigned)(j * 768)));
            else if (smp) { const float* sc = a.in[4] + (unsigned)((b * 3 + j) * 768 + gch); v = cvt2(sc[0], sc[1]); }
            raw[i][j] = v; }
        __builtin_amdgcn_sched_barrier(0); }
    if (tid < 256) dtr_v = DTR[(unsigned)((tok0 + tt_) * 8 + g * 4 + h4)];
    { SSD_LANE();
#pragma unroll
      for (int j = 0; j < 2; ++j)
#pragma unroll
          for (int q = 0; q < 4; ++q) { zc[j][q] = (u32x2){0u, 0u}; if (full) zc[j][q] = *(const u32x2*)(Z + (unsigned)((tok0 + 32 * j + lr) * 512 + g * 256 + hh * 64 + 32 * ph + 4 * hi + 8 * q)); } }
    for (int i = tid; i < 5 * 384; i += NTHR) { const int k = i / 384, lc = i - k * 384, gch = ssd_gch(lc, g); CW[i] = k < 4 ? a.in[8][k * 768 + gch] : a.in[9][gch]; }
    if (tid < 256) NW[tid] = a.in[13][g * 256 + tid];
    float hb = 0.f, hA = 0.f, hD = 0.f;
    if (tid < 256) { const int hd = g * 4 + h4; hb = a.in[10][hd]; hA = -__expf(a.in[11][hd]); hD = a.in[12][hd]; }
    f32x16 st[2];
    { SSD_LANE();
#pragma unroll
      for (int jn = 0; jn < 2; ++jn)
#pragma unroll
          for (int r = 0; r < 16; ++r) { float v = 0.f; if (smp) v = a.in[5][(((size_t)(b * 8 + head)) * 64 + 32 * ph + crow(r, hi)) * 64 + 32 * jn + lr]; st[jn][r] = v; }
      float lam_all = 0.f; if (full && !smp) lam_all = LAM[(unsigned)(((b * 2 + g) * 8 + (ln_ & 7)) * 4 + hh)];
      if (full && !smp)
#pragma unroll 2
      for (int s = 0; s < sc; ++s) { const unsigned ix = (unsigned)(((b * 2 + g) * 8 + s) * 4 + hh); const float dl = __builtin_amdgcn_exp2f(__shfl(lam_all, s)); const float* sp = SBUF + (size_t)ix * 4096;
#pragma unroll
          for (int jn = 0; jn < 2; ++jn)
#pragma unroll
              for (int r = 0; r < 16; ++r) st[jn][r] = dl * st[jn][r] + sp[(32 * ph + crow(r, hi)) * 64 + 32 * jn + lr]; }
#pragma unroll
      for (int jn = 0; jn < 2; ++jn)
#pragma unroll
          for (int r = 0; r < 16; ++r) HT[(32 * ph + crow(r, hi)) * TP + 32 * jn + lr] = (bf16_t)(cvt2(st[jn][r], st[jn][r]) & 0xffffu); }
#define SSD_STEP1(buf, dtr_) do { if (tid < 256) { const float raw_ = (dtr_) + hb; const float dt_ = raw_ > 20.f ? raw_ : log1pf(__expf(raw_)); float ac_ = hA * dt_; \
        _Pragma("unroll") for (int o = 1; o < 64; o <<= 1) { const float n_ = __shfl_up(ac_, o); if (tt_ >= o) ac_ += n_; } \
        const float a63_ = __shfl(ac_, 63); const int ix_ = h4 * 64 + tt_; \
        AUX(buf, 0)[ix_] = dt_; AUX(buf, 1)[ix_] = ac_ * LOG2E; AUX(buf, 2)[ix_] = __expf(a63_ - ac_); AUX(buf, 3)[ix_] = __expf(ac_); AUX(buf, 4)[ix_] = hD * __builtin_amdgcn_rcpf(dt_); } } while (0)
    SSD_STEP1(0, dtr_v);
    __syncthreads();
    for (int c = 0; c < nch; ++c) {
        const int T0 = tok0 + 64 * c, cur = c & 1; SSD_LANE(); int tl_ = tid; asm volatile("" : "+v"(tl_));
#pragma unroll
        for (int i = 0; i < 3; ++i) {
            const int it = tl_ + NTHR * i, cp = it % 192, ts = it / 192, lc = 2 * cp;
            float o0[8], o1[8];
            { float w0[5], w1[5];
#pragma unroll
              for (int k = 0; k < 5; ++k) { const f32x2 w = *(const LAS f32x2*)(CW + k * 384 + lc); w0[k] = w[0]; w1[k] = w[1]; }
#pragma unroll
              for (int tt = 0; tt < 8; ++tt) { float s0 = w0[4], s1 = w1[4];
#pragma unroll
                  for (int k = 0; k < 4; ++k) { s0 += w0[k] * bf_lo(raw[i][tt + k]); s1 += w1[k] * bf_hi(raw[i][tt + k]); }
                  o0[tt] = silu_f(s0); o1[tt] = silu_f(s1); } }
            if (full && last && c == nch - 1 && ts == 7) { float* co = a.out + (smp ? O_CS : O_CP) + (size_t)b * 3 * 768 + ssd_gch(lc, g);
#pragma unroll
                for (int j = 0; j < 3; ++j) { co[j * 768] = bf_lo(raw[i][8 + j]); co[j * 768 + 1] = bf_hi(raw[i][8 + j]); } }
            if (lc < 256) { const int h2 = lc >> 6, p = lc & 63;
                LAS bf16_t* xd = (LAS bf16_t*)(lds + L_XDT + h2 * TSZ) + p * TP + 8 * ts; LAS bf16_t* xe = (LAS bf16_t*)(lds + L_XDTE + h2 * TSZ) + p * TP + 8 * ts;
                float e0[8], e1[8];
#pragma unroll
                for (int q = 0; q < 2; ++q) { const f32x4 dt4 = *(const LAS f32x4*)(AUX(cur, 0) + h2 * 64 + 8 * ts + 4 * q), de4 = *(const LAS f32x4*)(AUX(cur, 2) + h2 * 64 + 8 * ts + 4 * q);
#pragma unroll
                    for (int e = 0; e < 4; ++e) { const int tt = 4 * q + e; o0[tt] *= dt4[e]; o1[tt] *= dt4[e]; e0[tt] = o0[tt] * de4[e]; e1[tt] = o1[tt] * de4[e]; } }
                u32x4 w; w.x = cvt2(o0[0], o0[1]); w.y = cvt2(o0[2], o0[3]); w.z = cvt2(o0[4], o0[5]); w.w = cvt2(o0[6], o0[7]); *(LAS u32x4*)xd = w;
                w.x = cvt2(o1[0], o1[1]); w.y = cvt2(o1[2], o1[3]); w.z = cvt2(o1[4], o1[5]); w.w = cvt2(o1[6], o1[7]); *(LAS u32x4*)(xd + TP) = w;
                w.x = cvt2(e0[0], e0[1]); w.y = cvt2(e0[2], e0[3]); w.z = cvt2(e0[4], e0[5]); w.w = cvt2(e0[6], e0[7]); *(LAS u32x4*)xe = w;
                w.x = cvt2(e1[0], e1[1]); w.y = cvt2(e1[2], e1[3]); w.z = cvt2(e1[4], e1[5]); w.w = cvt2(e1[6], e1[7]); *(LAS u32x4*)(xe + TP) = w;
            } else if (lc < 320) { const int n = lc - 256;
#pragma unroll
                for (int tt = 0; tt < 8; ++tt) *(LAS unsigned*)(BM + (8 * ts + tt) * TP + n) = cvt2(o0[tt], o1[tt]);
                u32x4 w; w.x = cvt2(o0[0], o0[1]); w.y = cvt2(o0[2], o0[3]); w.z = cvt2(o0[4], o0[5]); w.w = cvt2(o0[6], o0[7]); *(LAS u32x4*)(BT + n * TP + 8 * ts) = w;
                w.x = cvt2(o1[0], o1[1]); w.y = cvt2(o1[2], o1[3]); w.z = cvt2(o1[4], o1[5]); w.w = cvt2(o1[6], o1[7]); *(LAS u32x4*)(BT + (n + 1) * TP + 8 * ts) = w;
            } else { const int n = lc - 320;
#pragma unroll
                for (int tt = 0; tt < 8; ++tt) *(LAS unsigned*)(CM + (8 * ts + tt) * TP + n) = cvt2(o0[tt], o1[tt]); }
            __builtin_amdgcn_sched_barrier(0);
        }
        __syncthreads();
        { const int Tn = (c + 1 < nch) ? T0 + 64 : T0;
#pragma unroll
            for (int i = 0; i < 3; ++i) { const int it = tl_ + NTHR * i, cp = it % 192, ts = it / 192; const unsigned o0 = (unsigned)((Tn + 8 * ts - 3) * 768 + ssd_gch(2 * cp, g));
#pragma unroll
                for (int j = 0; j < 11; ++j) raw[i][j] = *(const unsigned*)(XBC + (o0 + (unsigned)(j * 768))); }
            dtr_v = DTR[(unsigned)((Tn + tt_) * 8 + g * 4 + h4)];
        }
        __builtin_amdgcn_sched_barrier(0);
        if (full) {
        f32x16 yT[2];
#pragma unroll
        for (int j = 0; j < 2; ++j) {
#pragma unroll
            for (int r = 0; r < 16; ++r) yT[j][r] = 0.f;
#pragma unroll
            for (int ks = 0; ks < 4; ++ks) yT[j] = mfma32(ld16(HT + (32 * ph + lr) * TP + 16 * ks + 8 * hi), ld16(CM + (32 * j + lr) * TP + 16 * ks + 8 * hi), yT[j]);
            const int l = 32 * j + lr; const float al = AUX(cur, 1)[hh * 64 + l], ea = AUX(cur, 3)[hh * 64 + l], dsk = AUX(cur, 4)[hh * 64 + l];
#pragma unroll
            for (int r = 0; r < 16; ++r) yT[j][r] *= ea;
            for (int sb = 0; sb <= j; ++sb) {
                f32x16 GT;
#pragma unroll
                for (int r = 0; r < 16; ++r) GT[r] = 0.f;
#pragma unroll
                for (int ks = 0; ks < 4; ++ks) GT = mfma32(ld16(BM + (32 * sb + pi32(lr)) * TP + 16 * ks + 8 * hi), ld16(CM + (32 * j + lr) * TP + 16 * ks + 8 * hi), GT);
                const LAS f32x4* as4 = (const LAS f32x4*)(AUX(cur, 1) + hh * 64 + 32 * sb + 16 * hi);
                float gv[16];
#pragma unroll
                for (int q = 0; q < 4; ++q) { const f32x4 as = as4[q];
#pragma unroll
                    for (int e = 0; e < 4; ++e) { const int r = 4 * q + e, s = 32 * sb + 16 * hi + r; const float ex = __builtin_amdgcn_exp2f(al - as[e]);
                        float v = GT[r] * ex;
                        if (sb == j) { v = (s <= l) ? v : 0.f; if (s == l) v += dsk; }
                        gv[r] = v; } }
                u32x4 w; w.x = cvt2(gv[0], gv[1]); w.y = cvt2(gv[2], gv[3]); w.z = cvt2(gv[4], gv[5]); w.w = cvt2(gv[6], gv[7]); const bf16x8 pb0 = __builtin_bit_cast(bf16x8, w);
                w.x = cvt2(gv[8], gv[9]); w.y = cvt2(gv[10], gv[11]); w.z = cvt2(gv[12], gv[13]); w.w = cvt2(gv[14], gv[15]); const bf16x8 pb1 = __builtin_bit_cast(bf16x8, w);
                yT[j] = mfma32(ld16(XDT + (32 * ph + lr) * TP + 32 * sb + 16 * hi), pb0, yT[j]);
                yT[j] = mfma32(ld16(XDT + (32 * ph + lr) * TP + 32 * sb + 16 * hi + 8), pb1, yT[j]);
            }
        }
        __builtin_amdgcn_sched_barrier(0);
#pragma unroll
        for (int j = 0; j < 2; ++j) { float ssq = 0.f;
#pragma unroll
            for (int q = 0; q < 4; ++q) { const u32x2 zw = zc[j][q]; const float z4[4] = {bf_lo(zw.x), bf_hi(zw.x), bf_lo(zw.y), bf_hi(zw.y)};
#pragma unroll
                for (int e = 0; e < 4; ++e) { const float v = yT[j][4 * q + e] * z4[e]; yT[j][4 * q + e] = v; ssq += v * v; } }
            ssq += __shfl_xor(ssq, 32);
            if (hi == 0) SSQ[wid * 64 + 32 * j + lr] = ssq; }
        __syncthreads();
        { const int Tn = (c + 1 < nch) ? T0 + 64 : T0;
#pragma unroll
            for (int j = 0; j < 2; ++j)
#pragma unroll
                for (int q = 0; q < 4; ++q) zc[j][q] = *(const u32x2*)(Z + (unsigned)((Tn + 32 * j + lr) * 512 + g * 256 + hh * 64 + 32 * ph + 4 * hi + 8 * q));
        }
#pragma unroll
        for (int j = 0; j < 2; ++j) { float tot = 0.f;
#pragma unroll
            for (int w8 = 0; w8 < 8; ++w8) tot += SSQ[w8 * 64 + 32 * j + lr];
            const float rs = rsqrtf(tot * (1.0f / 256.0f) + EPS);
            const int chl = hh * 64 + 32 * ph + 4 * hi; bf16_t* mr = MIX + (unsigned)((T0 + 32 * j + lr) * DM + 512 + g * 256 + chl);
#pragma unroll
            for (int q = 0; q < 4; ++q) { const f32x4 nw = *(const LAS f32x4*)(NW + chl + 8 * q);
                u32x2 w; w.x = cvt2(yT[j][4 * q] * rs * nw[0], yT[j][4 * q + 1] * rs * nw[1]); w.y = cvt2(yT[j][4 * q + 2] * rs * nw[2], yT[j][4 * q + 3] * rs * nw[3]); *(u32x2*)(mr + 8 * q) = w; } }
        }
        { const float dec = AUX(cur, 3)[hh * 64 + 63]; lam += AUX(cur, 1)[hh * 64 + 63];
#pragma unroll
          for (int jn = 0; jn < 2; ++jn) {
#pragma unroll
              for (int r = 0; r < 16; ++r) st[jn][r] *= dec;
#pragma unroll
              for (int ks = 0; ks < 4; ++ks) st[jn] = mfma32(ld16(XDTE + (32 * ph + lr) * TP + 16 * ks + 8 * hi), ld16(BT + (32 * jn + lr) * TP + 16 * ks + 8 * hi), st[jn]);
          }
          if (c + 1 < nch) {
              if (full) {
#pragma unroll
              for (int jn = 0; jn < 2; ++jn)
#pragma unroll
                  for (int r = 0; r < 16; ++r) HT[(32 * ph + crow(r, hi)) * TP + 32 * jn + lr] = (bf16_t)(cvt2(st[jn][r], st[jn][r]) & 0xffffu); }
              SSD_STEP1(cur ^ 1, dtr_v);
          } }
        __syncthreads();
    }
    if (!full) { SSD_LANE(); const unsigned ix = (unsigned)(((b * 2 + g) * 8 + sc) * 4 + hh); float* sp = SBUF + (size_t)ix * 4096; if (ph == 0 && ln_ == 0) LAM[ix] = lam;
#pragma unroll
      for (int jn = 0; jn < 2; ++jn)
#pragma unroll
          for (int r = 0; r < 16; ++r) sp[(32 * ph + crow(r, hi)) * 64 + 32 * jn + lr] = st[jn][r]; }
    else if (last) { SSD_LANE(); float* so = a.out + (smp ? O_SS : O_SP) + ((size_t)(b * 8 + head)) * 4096;
#pragma unroll
      for (int jn = 0; jn < 2; ++jn)
#pragma unroll
          for (int r = 0; r < 16; ++r) so[(32 * ph + crow(r, hi)) * 64 + 32 * jn + lr] = st[jn][r]; }
#undef SSD_LANE
#undef AUX
#undef SSD_STEP1
}

#define XB_TMO      128
#define XB_XCNT(j)  (256  + 64 * (j))
#define XB_XSUB(j)  (1280 + 64 * (j))
#define XB_XGEN(j)  (2304 + 64 * (j))
#define XB_TOP      3328
#define XB_TOPGEN   3392
#define XCD_BAR_WORDS 3456
#define XB_SPIN_CAP (1u << 18)

__device__ __forceinline__ unsigned xb_ld(unsigned* p)              { return __hip_atomic_load(p, __ATOMIC_RELAXED, __HIP_MEMORY_SCOPE_AGENT); }
__device__ __forceinline__ unsigned xb_add(unsigned* p, unsigned v) { return __hip_atomic_fetch_add(p, v, __ATOMIC_RELAXED, __HIP_MEMORY_SCOPE_AGENT); }
__device__ __forceinline__ unsigned xb_xcc_id() { return (unsigned)__builtin_amdgcn_s_getreg((3 << 11) | 20) & 0xFu; }
#define XB_SPIN(cond, bar) do { unsigned _sp = 0; while (cond) { __builtin_amdgcn_s_sleep(1); \
    if ((++_sp & 255u) == 0u) { if (xb_ld(&(bar)[XB_TMO])) break; if (_sp > XB_SPIN_CAP) { atomicAdd(&(bar)[XB_TMO], 1u); break; } } } } while (0)

struct XcdBarrier {
    unsigned* bar; unsigned x;
    volatile LAS unsigned* st;
};

__device__ __forceinline__ XcdBarrier xcd_barrier_post(unsigned* bar, volatile LAS unsigned* st) {
    XcdBarrier b; b.bar = bar; b.x = xb_xcc_id(); b.st = st;
    if (threadIdx.x == 0) (void)xb_add(&bar[XB_XCNT(b.x)], 1u);
    return b;
}
__device__ __forceinline__ void xcd_barrier_complete(unsigned* bar, unsigned x, unsigned& nloc, unsigned& nx) {
    const unsigned G = gridDim.x * gridDim.y * gridDim.z;
    unsigned sum, cnt, mine, sp = 0u;
    for (;;) {
        sum = 0u; cnt = 0u; mine = 0u;
#pragma unroll
        for (unsigned j = 0; j < 16; ++j) { const unsigned c = xb_ld(&bar[XB_XCNT(j)]); sum += c; cnt += (c > 0u) ? 1u : 0u; mine = (j == x) ? c : mine; }
        if (sum == G) break;
        __builtin_amdgcn_s_sleep(1);
        if ((++sp & 255u) == 0u) { if (xb_ld(&bar[XB_TMO])) break; if (sp > XB_SPIN_CAP) { atomicAdd(&bar[XB_TMO], 1u); break; } }
    }
    nloc = mine > 0u ? mine : 1u; nx = cnt > 0u ? cnt : 1u;
}

__device__ __forceinline__ void xcd_barrier(const XcdBarrier& b) {
    asm volatile("s_waitcnt vmcnt(0)" ::: "memory");
    __syncthreads();
    if (threadIdx.x == 0) {
        unsigned* bar = b.bar;
        __builtin_amdgcn_s_waitcnt(0);
        unsigned nloc = b.st[0], nx = b.st[1];
        if (nloc == 0u) { xcd_barrier_complete(bar, b.x, nloc, nx); b.st[0] = nloc; b.st[1] = nx; }
        const unsigned old = xb_add(&bar[XB_XSUB(b.x)], 1u);
        const unsigned gen = old / nloc;
        if (old + 1u == (gen + 1u) * nloc) {
            __builtin_amdgcn_fence(__ATOMIC_RELEASE, "agent");
            asm volatile("s_waitcnt vmcnt(0)" ::: "memory");
            const unsigned og = xb_add(&bar[XB_TOP], 1u);
            const unsigned tg = og / nx;
            if (og + 1u == (tg + 1u) * nx) xb_add(&bar[XB_TOPGEN], 1u);
            else XB_SPIN(xb_ld(&bar[XB_TOPGEN]) == tg, bar);
            __builtin_amdgcn_fence(__ATOMIC_ACQUIRE, "agent");
            xb_add(&bar[XB_XGEN(b.x)], 1u);
            asm volatile("s_waitcnt vmcnt(0)" ::: "memory");
        } else {
            XB_SPIN(xb_ld(&bar[XB_XGEN(b.x)]) == gen, bar);
            __builtin_amdgcn_fence(__ATOMIC_ACQUIRE, "agent");
            asm volatile("s_waitcnt vmcnt(0)" ::: "memory");
        }
    }
    __syncthreads();
}

__global__ void __launch_bounds__(NTHR, 2) hybrid_fwd(Args a) {
    extern __shared__ __attribute__((aligned(16))) unsigned char lds_raw[];
    LAS unsigned char* lds = (LAS unsigned char*)lds_raw;
    cg::grid_group grid = cg::this_grid();
    unsigned char* ws = a.ws; const int G = gridDim.x;
    if (gridDim.x == 0x7fffffffu) grid.sync();
    volatile LAS unsigned* bst = (volatile LAS unsigned*)(lds + QSLOT_OFF + 16);
    if (threadIdx.x == 0) { bst[0] = 0u; bst[1] = 0u; }
    __syncthreads();
    const XcdBarrier bar = xcd_barrier_post((unsigned*)(ws + WS_CTL) + CW_BAR, bst);
#define GRID_SYNC() xcd_barrier(bar)
#define PHASE_IDS() int tid = threadIdx.x; asm volatile("" : "+v"(tid)); const int lane = tid & 63, wid = __builtin_amdgcn_readfirstlane(tid >> 6)

#ifndef SKIP_P0
    { PHASE_IDS(); p0_prologue(a, lds, tid, wid, lane); }
#endif
    GRID_SYNC();

#ifndef SKIP_P1
    { pg8::Gemm g{(const bf16_t*)(ws + WS_XB), (const bf16_t*)(ws + WS_WIN), NPR, NPROJ, DM, DM}; pg8::StaticOrder S; S.init(NPR, NPROJ, G, (int)blockIdx.x);
      EpiInProj E{(const float*)(ws + WS_RSTD1), a.out, ws, lds};
      pg8::gemm_phase<EpiInProj, pg8::StaticOrder, true, true>(lds, g, S, E); }
#endif
    GRID_SYNC();

#ifndef SKIP_P2
    for (int sp = 0; sp < 2; ++sp)
    { const int tid_p = threadIdx.x; unsigned* ctl = (unsigned*)(ws + WS_CTL) + sp; volatile LAS unsigned* qslot = (volatile LAS unsigned*)(lds + QSLOT_OFF);
      const bf16_t* Q = (const bf16_t*)(ws + WS_Q); const bf16_t* K = (const bf16_t*)(ws + WS_K); const bf16_t* KS = (const bf16_t*)(ws + WS_KS);
      const bf16_t* VTP = (const bf16_t*)(ws + WS_VTP); const bf16_t* VTS = (const bf16_t*)(ws + WS_VTS); bf16_t* MIX = (bf16_t*)(ws + WS_MIX);
      constexpr int N_SSDA = 448, N_GEMS = 88, N_SSDS = 64, N_ATTS = 64, N_ATTP = 1024, N_ATTP_A = 704, N_SSDC = 512;
      const int nitems = sp == 0 ? N_GEMS + N_SSDA + N_ATTP_A : N_SSDC + N_SSDS + N_ATTS + (N_ATTP - N_ATTP_A);
      for (;;) {
          if (tid_p == 0) *qslot = __hip_atomic_fetch_add(ctl, 1u, __ATOMIC_RELAXED, __HIP_MEMORY_SCOPE_AGENT);
          __syncthreads();
          int item = (int)*qslot;
          __syncthreads();
          if (item >= nitems) break;
          int tid = tid_p; asm volatile("" : "+v"(tid)); const int lane = tid & 63, wid = __builtin_amdgcn_readfirstlane(tid >> 6);
          int kind, s_b = 0, s_g = 0, s_sc = 0, s_mode = 0, aidx = 0; bool s_smp = false;
          if (sp == 0) {
              if (item < N_GEMS) { kind = 3; aidx = item; }
              else if (item < N_GEMS + N_SSDA) { kind = 0; const int it2 = item - N_GEMS, bg = it2 / 7; s_sc = it2 - bg * 7; s_b = bg >> 1; s_g = bg & 1; s_mode = 0; }
              else { kind = 1; aidx = item - N_GEMS - N_SSDA; }
          } else {
              if (item < N_SSDC) { kind = 0; s_sc = item & 7; const int bg = item >> 3; s_b = bg >> 1; s_g = bg & 1; s_mode = 1; }
              else if (item < N_SSDC + N_SSDS) { kind = 0; const int bg = item - N_SSDC; s_b = bg >> 1; s_g = bg & 1; s_smp = true; s_mode = 1; }
              else if (item < N_SSDC + N_SSDS + N_ATTS) { kind = 2; aidx = item - N_SSDC - N_SSDS; }
              else { kind = 1; aidx = item - N_SSDC - N_SSDS - N_ATTS + N_ATTP_A; }
          }
          if (kind == 3) {
              pg8::Gemm g{(const bf16_t*)(ws + WS_XB), (const bf16_t*)(ws + WS_WIN), MTOK, NPROJ, DM, DM}; TailOrder S1{256 + aidx / 11, aidx % 11};
              EpiInProj E{(const float*)(ws + WS_RSTD1), a.out, ws, lds};
              pg8::gemm_phase<EpiInProj, TailOrder, true, true>(lds, g, S1, E);
              __syncthreads();
          } else if (kind == 0) {
#ifndef SKIP_SSD
              ssd_item(a, lds, s_b, s_g, s_smp, s_sc, s_mode, tid, wid, lane);
#endif
          } else {
#ifndef SKIP_ATT
              const int nu = kind == 1 ? 2 : 1;
              for (int u = 0; u < nu; ++u) {
                  int bb, hh_, q0, qpos0, vp; const bf16_t *Qp, *Kp, *Vtp; bf16_t* Op;
                  if (kind == 1) { const int bh = aidx >> 2, quarter = aidx & 3; bb = bh >> 3; hh_ = bh & 7; const int qb = 16 * quarter + (u ? 15 - wid : wid); q0 = 32 * qb; qpos0 = q0; vp = 2048;
                      Qp = Q + (size_t)(bb * 2048 + q0) * 512 + hh_ * 64; Kp = K + (size_t)(bb * 2048) * 512 + hh_ * 64; Vtp = VTP + (size_t)(bb * 512 + hh_ * 64) * 2048; Op = MIX + (size_t)(bb * 2048 + q0) * DM + hh_ * 64; }
                  else { const int id = aidx * 8 + wid, bh = id >> 1; q0 = 32 * (id & 1); bb = bh >> 3; hh_ = bh & 7; qpos0 = 1024 + q0; vp = 1088;
                      Qp = Q + (size_t)(NPR + bb * 64 + q0) * 512 + hh_ * 64; Kp = KS + (size_t)(bb * 1088) * 512 + hh_ * 64; Vtp = VTS + (size_t)(bb * 512 + hh_ * 64) * 1088; Op = MIX + (size_t)(NPR + bb * 64 + q0) * DM + hh_ * 64; }
                  LAS bf16_t* astg = (LAS bf16_t*)(lds + wid * 18432);
                  if (kind == 1) attn_unit<false>(Qp, Kp, Vtp, vp, qpos0, Op, nullptr, nullptr, astg, lane);
                  else attn_unit<true>(Qp, Kp, Vtp, vp, qpos0, Op, a.in[2] + (size_t)(bb * 1024) * 512 + hh_ * 64, a.in[3] + (size_t)(bb * 1024) * 512 + hh_ * 64, astg, lane);
              }
#endif
          }
      }
      if (sp == 0) GRID_SYNC(); }
#endif
    GRID_SYNC();

#ifndef SKIP_P3
    { pg8::Gemm g{(const bf16_t*)(ws + WS_MIX), (const bf16_t*)(ws + WS_WOUT), MTOK, DM, DM, DM}; pg8::StaticOrder S; S.init(MTOK, DM, G, (int)blockIdx.x);
      EpiOutProj E{(const bf16_t*)(ws + WS_XB), (bf16_t*)(ws + WS_HB), (float*)(ws + WS_SSQ2), lds};
      pg8::gemm_phase<EpiOutProj, pg8::StaticOrder, true, true>(lds, g, S, E); }
#endif
    GRID_SYNC();

#ifndef SKIP_P4
    { pg8::Gemm g{(const bf16_t*)(ws + WS_HB), (const bf16_t*)(ws + WS_WUP), MTOK, DFF, DM, DM}; pg8::StaticOrder S; S.init(MTOK, DFF, G, (int)blockIdx.x);
      EpiUp E{(const float*)(ws + WS_SSQ2), (bf16_t*)(ws + WS_U), lds};
      pg8::gemm_phase<EpiUp, pg8::StaticOrder, true, true>(lds, g, S, E); }
#endif
    GRID_SYNC();

#ifndef SKIP_P5
    { pg8::Gemm g{(const bf16_t*)(ws + WS_U), (const bf16_t*)(ws + WS_WDN), NPR, DM, DFF, DFF}; pg8::StaticOrder S; S.init(NPR, DM, G, (int)blockIdx.x);
      EpiDown E{(bf16_t*)(ws + WS_HB), lds};
      pg8::gemm_phase<EpiDown, pg8::StaticOrder, true, true>(lds, g, S, E);
      if (G == 256) { const int c = (int)blockIdx.x, k = c >> 3, unit = (c & 7) + 8 * (k >> 3), slice = k & 7;
          pg8::Gemm gt{(const bf16_t*)(ws + WS_U) + slice * 512, (const bf16_t*)(ws + WS_WDN) + slice * 512, MTOK, DM, 512, DFF};
          TailOrder St{256 + (unit >> 2), unit & 3}; EpiDownPart Et{(float*)(ws + WS_PART) + (size_t)slice * NSM * DM};
          pg8::gemm_phase<EpiDownPart, TailOrder, true, true>(lds, gt, St, Et); }
      else { pg8::Gemm gt{(const bf16_t*)(ws + WS_U), (const bf16_t*)(ws + WS_WDN), MTOK, DM, DFF, DFF}; TailAll St; St.init(G, (int)blockIdx.x); EpiDownPart Et{(float*)(ws + WS_PART)};
          float* pz = (float*)(ws + WS_PART) + (size_t)NSM * DM; for (size_t i = (size_t)blockIdx.x * NTHR + threadIdx.x; i < (size_t)7 * NSM * DM; i += (size_t)G * NTHR) pz[i] = 0.f;
          pg8::gemm_phase<EpiDownPart, TailAll, true, true>(lds, gt, St, Et); } }
#endif
    GRID_SYNC();

#ifndef SKIP_P6
    { PHASE_IDS(); const float* fw = a.in[18]; float* Y = a.out + O_Y; const int gw = blockIdx.x * NWAVES + wid, NGW = G * NWAVES;
      f32x4 w4[4];
#pragma unroll
      for (int j = 0; j < 4; ++j) w4[j] = *(const f32x4*)(fw + 256 * j + 4 * lane);
      const bf16_t* HBp = (const bf16_t*)(ws + WS_HB);
      u32x2 c0[4], c1[4], c2[4];
      { const int r1 = gw + NGW < MTOK ? gw + NGW : gw, r2 = gw + 2 * NGW < MTOK ? gw + 2 * NGW : gw;
#pragma unroll
        for (int j = 0; j < 4; ++j) { c0[j] = *(const u32x2*)(HBp + (size_t)gw * DM + 4 * lane + 256 * j); c1[j] = *(const u32x2*)(HBp + (size_t)r1 * DM + 4 * lane + 256 * j); c2[j] = *(const u32x2*)(HBp + (size_t)r2 * DM + 4 * lane + 256 * j); } }
      for (int row = gw; row < MTOK; row += NGW) { float* yr = Y + (size_t)row * DM + 4 * lane; const int nrow = row + 3 * NGW; u32x2 cn[4]; float ss = 0.f; f32x4 v[4];
#pragma unroll
          for (int j = 0; j < 4; ++j) cn[j] = *(const u32x2*)(HBp + (size_t)(nrow < MTOK ? nrow : row) * DM + 4 * lane + 256 * j);
#pragma unroll
          for (int j = 0; j < 4; ++j) v[j] = (f32x4){bf_lo(c0[j].x), bf_hi(c0[j].x), bf_lo(c0[j].y), bf_hi(c0[j].y)};
          if (row >= NPR) { const float* pr = (const float*)(ws + WS_PART) + (size_t)(row - NPR) * DM + 4 * lane;
              for (int sl = 0; sl < 8; ++sl)
#pragma unroll
                  for (int j = 0; j < 4; ++j) v[j] += *(const f32x4*)(pr + (size_t)sl * NSM * DM + 256 * j); }
#pragma unroll
          for (int j = 0; j < 4; ++j) ss += (v[j][0] * v[j][0] + v[j][1] * v[j][1]) + (v[j][2] * v[j][2] + v[j][3] * v[j][3]);
          const float rs = rsqrtf(wave_sum(ss) * (1.0f / DM) + EPS);
#pragma unroll
          for (int j = 0; j < 4; ++j) { *(f32x4*)(yr + 256 * j) = v[j] * rs * w4[j]; c0[j] = c1[j]; c1[j] = c2[j]; c2[j] = cn[j]; } } }
#endif
}

extern "C" void kernel_launch(void* const* d_in, const int* in_sizes, int n_in, void* d_out, int out_size, void* d_ws, size_t ws_size, hipStream_t stream) {
    static int grid = 0;
    if (grid == 0) {
        if (n_in != 19 || (size_t)out_size != O_END || ws_size < WS_END) { fprintf(stderr, "kernel_launch: unexpected shapes (n_in %d, out %d, ws %zu)\n", n_in, out_size, ws_size); grid = -1; return; }
        int dev = 0, cus = 0, per_cu = 0;
        hipGetDevice(&dev); hipDeviceGetAttribute(&cus, hipDeviceAttributeMultiprocessorCount, dev);
        if (hipFuncSetAttribute((const void*)hybrid_fwd, hipFuncAttributeMaxDynamicSharedMemorySize, LDS_BYTES) != hipSuccess) { fprintf(stderr, "kernel_launch: hipFuncSetAttribute failed\n"); grid = -1; return; }
        if (hipOccupancyMaxActiveBlocksPerMultiprocessor(&per_cu, (const void*)hybrid_fwd, NTHR, LDS_BYTES) != hipSuccess || per_cu < 1) { fprintf(stderr, "kernel_launch: occupancy query says %d\n", per_cu); per_cu = 1; }
        (void)hipGetLastError();
        grid = cus * 1;
        if (grid <= 0) grid = 256;
    }
    if (grid < 0) return;
    if (hipMemsetAsync((char*)d_ws + WS_CTL + (size_t)CW_BAR * 4, 0, (size_t)XCD_BAR_WORDS * 4, stream) != hipSuccess) { fprintf(stderr, "kernel_launch: hipMemsetAsync of the barrier words failed\n"); return; }
    Args a{};
    for (int i = 0; i < 19; ++i) a.in[i] = (const float*)d_in[i];
    a.out = (float*)d_out; a.ws = (unsigned char*)d_ws;
    void* args[] = {&a};
    hipError_t e = hipLaunchCooperativeKernel((const void*)hybrid_fwd, dim3(grid), dim3(NTHR), args, LDS_BYTES, stream);
    if (e != hipSuccess) fprintf(stderr, "cooperative launch failed: %s (grid %d)\n", hipGetErrorString(e), grid);
}
```
